# Optimizing an MI355X kernel written in HIP

```python
import math
import jax, jax.numpy as jnp
from jax import lax
import numpy as np

D_MODEL = 1024
BATCH = 8
SEQ = 8192
DEPTH = 2

CTX_LEN = 256
GRID_W = 64
HEAD_DIM = 64
A_Q_HEADS = 6
A_KV_HEADS = 2
F_GROUPS = 4
F_GROUP_CH = 64
C_Q_HEADS = 6
C_KV_HEADS = 2
WINDOW = 128
Q_BLOCK = 128
ROPE_THETA = 10000.0
AXIS_ROT = HEAD_DIM // 2
D_FF = -(-8 * D_MODEL // (3 * 256)) * 256
NORM_EPS = 1e-6
NEG_INF = -1e30

Q_A_W = A_Q_HEADS * HEAD_DIM
KV_A_W = A_KV_HEADS * HEAD_DIM
F_W = F_GROUPS * F_GROUP_CH
Q_C_W = C_Q_HEADS * HEAD_DIM
KV_C_W = C_KV_HEADS * HEAD_DIM
IN_WIDTH = Q_A_W + 2 * KV_A_W + F_W + Q_C_W + 2 * KV_C_W
MIX_WIDTH = Q_A_W + F_W + Q_C_W

kernel_name = 'hybrid_dit_global_fourier_window_heads'


def rms_norm(x, g):
    xf = x.astype(jnp.float32)
    y = xf * lax.rsqrt(jnp.mean(xf * xf, axis=-1, keepdims=True) + NORM_EPS)
    return (y * g.astype(jnp.float32)).astype(x.dtype)


def adaln(cond, w_ada, b_ada):
    m = jax.nn.silu(cond) @ w_ada + b_ada
    return jnp.split(m, 6, axis=-1)


def axial_rope_tables(n_tokens):
    rows = n_tokens // GRID_W
    row = jnp.repeat(jnp.arange(rows, dtype=jnp.float32), GRID_W)
    col = jnp.tile(jnp.arange(GRID_W, dtype=jnp.float32), rows)
    inv_freq = ROPE_THETA ** (-jnp.arange(0, AXIS_ROT, 2, dtype=jnp.float32) / AXIS_ROT)
    ang = jnp.concatenate([row[:, None] * inv_freq, col[:, None] * inv_freq], axis=-1)
    return jnp.cos(ang), jnp.sin(ang)


def apply_rope(x, cos, sin):
    xf = x.astype(jnp.float32)
    half = HEAD_DIM // 2
    x1, x2 = xf[..., :half], xf[..., half:]
    c = cos[None, :, None, :]
    s = sin[None, :, None, :]
    return jnp.concatenate([x1 * c - x2 * s, x2 * c + x1 * s], axis=-1).astype(x.dtype)


def gqa_logits(q, k):
    b, lq, h, dh = q.shape
    kvh = k.shape[2]
    qg = q.reshape(b, lq, kvh, h // kvh, dh)
    return jnp.einsum('bqhgd,bkhd->bhgqk', qg, k, preferred_element_type=jnp.float32) * (dh ** -0.5)


def gqa_combine(p, v):
    o = jnp.einsum('bhgqk,bkhd->bqhgd', p.astype(v.dtype), v)
    return o.reshape(o.shape[0], o.shape[1], -1)


def sink_logits(sink, like):
    kvh, g = like.shape[1], like.shape[2]
    return jnp.broadcast_to(sink.astype(jnp.float32).reshape(1, kvh, g, 1, 1), like.shape[:-1] + (1,))


def dense_attention(q, k, v, sink=None):
    s = gqa_logits(q, k)
    if sink is None:
        return gqa_combine(jax.nn.softmax(s, axis=-1), v)
    s = jnp.concatenate([s, sink_logits(sink, s)], axis=-1)
    p = jax.nn.softmax(s, axis=-1)[..., :-1]
    return gqa_combine(p, v)


def global_attention(q, k, v, k_ctx, v_ctx):
    b, s, h, dh = q.shape
    nb = s // Q_BLOCK
    k_all = jnp.concatenate([k_ctx, k], axis=1)
    v_all = jnp.concatenate([v_ctx, v], axis=1)
    qb = jnp.moveaxis(q.reshape(b, nb, Q_BLOCK, h, dh), 1, 0)
    ob = lax.map(lambda qi: dense_attention(qi, k_all, v_all), qb)
    return jnp.moveaxis(ob, 0, 1).reshape(b, s, h * dh)


def window_attention(q, k, v, k_ctx, v_ctx, sink):
    b, s, h, dh = q.shape
    nb = s // Q_BLOCK
    band = Q_BLOCK + 2 * WINDOW
    n_ctx = k_ctx.shape[1]
    pad = ((0, 0), (WINDOW, WINDOW), (0, 0), (0, 0))
    kp = jnp.pad(k, pad)
    vp = jnp.pad(v, pad)
    qb = jnp.moveaxis(q.reshape(b, nb, Q_BLOCK, h, dh), 1, 0)
    qi_idx = jnp.arange(Q_BLOCK)[:, None]
    kj = jnp.arange(band)[None, :]
    in_window = jnp.abs(kj - WINDOW - qi_idx) <= WINDOW

    def one_block(args):
        qi, n = args
        start = n * Q_BLOCK
        kb = lax.dynamic_slice_in_dim(kp, start, band, axis=1)
        vb = lax.dynamic_slice_in_dim(vp, start, band, axis=1)
        kpos = start - WINDOW + kj
        valid = in_window & (kpos >= 0) & (kpos < s)
        s_loc = jnp.where(valid, gqa_logits(qi, kb), NEG_INF)
        s_ctx = gqa_logits(qi, k_ctx)
        logits = jnp.concatenate([s_loc, s_ctx, sink_logits(sink, s_loc)], axis=-1)
        p = jax.nn.softmax(logits, axis=-1)
        return gqa_combine(p[..., :band], vb) + gqa_combine(p[..., band:band + n_ctx], v_ctx)

    ob = lax.map(one_block, (qb, jnp.arange(nb)))
    return jnp.moveaxis(ob, 0, 1).reshape(b, s, h * dh)


def fourier_mix(u):
    b, l, _ = u.shape
    ug = u.astype(jnp.float32).reshape(b, l, F_GROUPS, F_GROUP_CH)
    f = jnp.fft.fftn(ug, axes=(1, 3), norm='ortho').real
    return f.reshape(b, l, F_W).astype(u.dtype)


def mixer_inputs(h, w_in, q_norm, k_norm, rope):
    b, l, _ = h.shape
    widths = (Q_A_W, KV_A_W, KV_A_W, F_W, Q_C_W, KV_C_W, KV_C_W)
    points = [int(p) for p in np.cumsum(widths)[:-1]]
    qa, ka, va, fb, qc, kc, vc = jnp.split(h @ w_in, points, axis=-1)
    qa = rms_norm(qa.reshape(b, l, A_Q_HEADS, HEAD_DIM), q_norm)
    ka = rms_norm(ka.reshape(b, l, A_KV_HEADS, HEAD_DIM), k_norm)
    va = va.reshape(b, l, A_KV_HEADS, HEAD_DIM)
    qc = qc.reshape(b, l, C_Q_HEADS, HEAD_DIM)
    kc = kc.reshape(b, l, C_KV_HEADS, HEAD_DIM)
    vc = vc.reshape(b, l, C_KV_HEADS, HEAD_DIM)
    if rope is not None:
        cos, sin = rope
        qa, ka = apply_rope(qa, cos, sin), apply_rope(ka, cos, sin)
        qc, kc = apply_rope(qc, cos, sin), apply_rope(kc, cos, sin)
    return qa, ka, va, fb, qc, kc, vc


def swiglu(h, w_gate, w_up, w_down):
    return (jax.nn.silu(h @ w_gate) * (h @ w_up)) @ w_down


def setup_inputs(seed: int = 0) -> dict:
    key = jax.random.key(seed)
    ks = jax.random.split(key, 18)
    n = jax.random.normal
    f32 = jnp.float32
    return {
        'x': n(ks[0], (BATCH, SEQ, D_MODEL), f32),
        'c': n(ks[1], (BATCH, D_MODEL), f32),
        'ctx': n(ks[2], (BATCH, CTX_LEN, D_MODEL), f32),
        'c_ctx': n(ks[3], (D_MODEL,), f32),
        'w_ada': 0.02 * n(ks[4], (DEPTH, D_MODEL, 6 * D_MODEL), f32),
        'b_ada': 0.01 * n(ks[5], (DEPTH, 6 * D_MODEL), f32),
        'g_mix': 1.0 + 0.05 * n(ks[6], (DEPTH, D_MODEL), f32),
        'g_ffn': 1.0 + 0.05 * n(ks[7], (DEPTH, D_MODEL), f32),
        'w_in': n(ks[8], (DEPTH, D_MODEL, IN_WIDTH), f32) * D_MODEL ** -0.5,
        'q_norm': 1.0 + 0.05 * n(ks[9], (DEPTH, HEAD_DIM), f32),
        'k_norm': 1.0 + 0.05 * n(ks[10], (DEPTH, HEAD_DIM), f32),
        'sink': 0.5 * n(ks[11], (DEPTH, C_Q_HEADS), f32),
        'w_out': n(ks[12], (DEPTH, MIX_WIDTH, D_MODEL), f32) * MIX_WIDTH ** -0.5,
        'w_gate': n(ks[13], (DEPTH, D_MODEL, D_FF), f32) * D_MODEL ** -0.5,
        'w_up': n(ks[14], (DEPTH, D_MODEL, D_FF), f32) * D_MODEL ** -0.5,
        'w_down': n(ks[15], (DEPTH, D_FF, D_MODEL), f32) * D_FF ** -0.5,
        'g_final': 1.0 + 0.05 * n(ks[16], (D_MODEL,), f32),
    }


def reference(x, c, ctx, c_ctx, w_ada, b_ada, g_mix, g_ffn, w_in, q_norm, k_norm, sink, w_out, w_gate, w_up, w_down, g_final):
    rope = axial_rope_tables(x.shape[1])
    for l in range(DEPTH):
        update_ctx = l < DEPTH - 1
        sh1, sc1, gt1, sh2, sc2, gt2 = [m[:, None, :] for m in adaln(c, w_ada[l], b_ada[l])]
        csh1, csc1, cgt1, csh2, csc2, cgt2 = adaln(c_ctx, w_ada[l], b_ada[l])
        h = rms_norm(x, g_mix[l]) * (1 + sc1) + sh1
        hc = rms_norm(ctx, g_mix[l]) * (1 + csc1) + csh1
        qa, ka, va, fb, qc, kc, vc = mixer_inputs(h, w_in[l], q_norm[l], k_norm[l], rope)
        qac, kac, vac, fbc, qcc, kcc, vcc = mixer_inputs(hc, w_in[l], q_norm[l], k_norm[l], None)
        o = jnp.concatenate([
            global_attention(qa, ka, va, kac, vac),
            fourier_mix(fb),
            window_attention(qc, kc, vc, kcc, vcc, sink[l]),
        ], axis=-1)
        x = x + gt1 * (o @ w_out[l])
        x = x + gt2 * swiglu(rms_norm(x, g_ffn[l]) * (1 + sc2) + sh2, w_gate[l], w_up[l], w_down[l])
        if update_ctx:
            oc = jnp.concatenate([
                dense_attention(qac, kac, vac),
                fourier_mix(fbc),
                dense_attention(qcc, kcc, vcc, sink[l]),
            ], axis=-1)
            ctx = ctx + cgt1 * (oc @ w_out[l])
            ctx = ctx + cgt2 * swiglu(rms_norm(ctx, g_ffn[l]) * (1 + csc2) + csh2, w_gate[l], w_up[l], w_down[l])
    return rms_norm(x, g_final)
```

```cpp
#include <hip/hip_runtime.h>
#include <hip/hip_cooperative_groups.h>
#include <cstdio>
#include <cstdint>
#include <hip/hip_bf16.h>
#include <cmath>
namespace pg8 {
#define PG8_LAS __attribute__((address_space(3)))
typedef unsigned short bf16_t;
typedef short bf16x8 __attribute__((ext_vector_type(8)));
typedef float f32x4 __attribute__((ext_vector_type(4)));
typedef unsigned u32x4 __attribute__((ext_vector_type(4)));
constexpr int BM = 256, BK = 64, HALF = 128, HTB = HALF * BK * 2  , STAGE_BYTES = 8 * HTB, NXCD = 8, WGM = 4;

__host__ __device__ __forceinline__ int lds_byte(int r, int c) { const int st = (r >> 4) * 2 + (c >> 5), rr = r & 15, cc = c & 31, ob = rr * 64 + cc * 2; return st * 1024 + (ob ^ (((ob >> 9) & 1) << 5)); }
__host__ __device__ __forceinline__ void stage_rc(int b, int& R, int& C) { const int st = b / 1024, sb = b % 1024, swz = sb ^ (((sb >> 9) & 1) << 5); R = (st >> 1) * 16 + swz / 64; C = (st & 1) * 32 + (swz % 64) / 2; }
__host__ __device__ __forceinline__ int perm32(int rho) { const int n = rho >> 4, i = rho & 15; return 8 * (i >> 2) + 4 * n + (i & 3); }

struct Unit { int pm, pn; };
struct Gemm { const bf16_t* A; const bf16_t* Bt; int M, N, K; };

struct StaticOrder {
    int nM, nN, nwg, G, c;
    __host__ __device__ void init(int M, int N, int G_, int c_) { nM = M / BM; nN = N / BM; nwg = nM * nN; G = G_; c = c_; }
    __host__ __device__ bool next(int i, Unit& u) const {
        const long L = (long)i * G + c; if (L >= nwg) return false;
        int wgid = (int)L; { const int q = nwg / NXCD, r = nwg % NXCD, xcd = wgid % NXCD, off = wgid / NXCD; wgid = (xcd < r ? xcd * (q + 1) : r * (q + 1) + (xcd - r) * q) + off; }
        const int nig = WGM * nN, gid = wgid / nig, fm = gid * WGM, gsz = (nM - fm) < WGM ? (nM - fm) : WGM;
        u.pm = fm + ((wgid % nig) % gsz); u.pn = (wgid % nig) / gsz; return true;
    }
    __device__ __forceinline__ void a_ready(const Unit&) const {}
    __device__ __forceinline__ void done(const Unit&) const {}
};

__device__ __forceinline__ unsigned cvt_pk_bf16(float lo, float hi) { unsigned r; asm volatile("v_cvt_pk_bf16_f32 %0, %1, %2" : "=v"(r) : "v"(lo), "v"(hi)); return r; }
typedef float f32x2 __attribute__((ext_vector_type(2)));
template <int XM> __device__ __forceinline__ float lane_xor_add(float v) {
    if constexpr (XM == 32) { const auto rr = __builtin_amdgcn_permlane32_swap(__float_as_uint(v), __float_as_uint(v), false, false); return __uint_as_float(rr[0]) + __uint_as_float(rr[1]); }
    else return v + __uint_as_float((unsigned)__builtin_amdgcn_ds_swizzle((int)__float_as_uint(v), (XM << 10) | 0x1f));
}
typedef unsigned u32x4 __attribute__((ext_vector_type(4)));
constexpr float QK_C2 = 0.125f * 1.4426950408889634f;
constexpr int BR_TILES = 33;

struct RowOrder {
    StaticOrder s; int mode, nn;
    __host__ __device__ void init(int N, int G_, int c_, int mode_) { mode = mode_; nn = N / BM; s.init(mode_ == 1 ? 65536 : 67584, N, G_, c_); }
    __host__ __device__ bool next(int i, Unit& u) const {
        if (mode == 2) { if (i != 0 || s.c >= 8 * nn) return false; u.pm = (s.c / nn) * 33; u.pn = s.c % nn; return true; }
        if (!s.next(i, u)) return false; if (mode == 1) u.pm = u.pm + (u.pm >> 5) + 1; return true; }
    __device__ __forceinline__ void a_ready(const Unit&) const {}
    __device__ __forceinline__ void done(const Unit&) const {}
};

struct EpiInProj {
    static constexpr bool PERM = true, AFTER_DRAIN = false;
    bf16_t* P; bf16_t* UT; bf16_t* UTc; const float* qn; const float* kn;
    __device__ __forceinline__ void operator()(const f32x4 (&acc)[2][2][4][2], const Unit& u, int wr, int wc, int fr, int fq) const {
        const int b = u.pm / BR_TILES, pt = u.pm % BR_TILES; const bool is_ctx = (pt == 0);
        const int slot = u.pn * 4 + wc;
        const int rloc = wr * 64 + fr;
        if (slot >= 20) {
            const int which = (slot - 20) >> 2, g = (slot - 20) & 3, qi = fr & 3; const bool r1 = (fr & 1) != 0, h1 = (fr & 2) != 0;
            const unsigned selB = r1 ? 0x03020706u : 0x05040100u;
            bf16_t* base; size_t pitch;
            if (is_ctx) { base = UTc + (size_t)(b * 256 + g * 64) * 512 + which * 256 + (rloc - qi); pitch = 512; }
            else { base = UT + (size_t)(b * 256 + g * 64) * 16384 + which * 8192 + (pt - 1) * 256 + (rloc - qi); pitch = 16384; }
            typedef unsigned u32x2 __attribute__((ext_vector_type(2)));
#pragma unroll
            for (int ai = 0; ai < 2; ++ai)
#pragma unroll
                for (int m = 0; m < 4; ++m)
#pragma unroll
                    for (int bj = 0; bj < 2; ++bj)
#pragma unroll
                        for (int n = 0; n < 2; ++n) { const f32x4 v = acc[ai][bj][m][n]; const unsigned w0 = cvt_pk_bf16(v[0], v[1]), w1 = cvt_pk_bf16(v[2], v[3]);
                            const unsigned snd = h1 ? w0 : w1, rcv = (unsigned)__builtin_amdgcn_update_dpp(0, (int)snd, 0x4E, 0xF, 0xF, true);
                            const unsigned a0 = h1 ? rcv : w0, a1 = h1 ? w1 : rcv;
                            const unsigned p0 = (unsigned)__builtin_amdgcn_update_dpp(0, (int)a0, 0xB1, 0xF, 0xF, true), p1 = (unsigned)__builtin_amdgcn_update_dpp(0, (int)a1, 0xB1, 0xF, 0xF, true);
                            u32x2 x; x.x = __builtin_amdgcn_perm(p0, a0, selB); x.y = __builtin_amdgcn_perm(p1, a1, selB);
                            *(u32x2*)(base + (size_t)(32 * bj + 8 * fq + 4 * n + qi) * pitch + ai * 128 + m * 16) = x; }
            return;
        }
        const bool isq = slot < 6 || (slot >= 10 && slot < 16);
        const bool isk = slot == 6 || slot == 7 || slot == 16 || slot == 17;
        const bool donorm = slot < 8;
        const bool dorope = (isq || isk) && !is_ctx;
        const float* gam = slot < 6 ? qn : kn;
        f32x4 gv[2][2];
#pragma unroll
        for (int bj = 0; bj < 2; ++bj)
#pragma unroll
            for (int n = 0; n < 2; ++n) gv[bj][n] = donorm ? *(const f32x4*)(gam + 32 * bj + 8 * fq + 4 * n) : (f32x4){1.f, 1.f, 1.f, 1.f};
        const float qs = isq ? QK_C2 : 1.f;
        bf16_t* orow0 = P + (size_t)(u.pm * 256 + rloc) * 1280 + slot * 64 + 8 * fq;
        float rf[2][4];
#pragma unroll
        for (int n = 0; n < 2; ++n)
#pragma unroll
            for (int j = 0; j < 4; ++j) rf[n][j] = __builtin_amdgcn_exp2f(-(float)((8 * fq + 4 * n + j) & 15) * (13.287712379549449f / 16.0f)) * 0.15915494309189535f;
        const int tl0 = (pt - 1) * 256 + rloc;
#pragma unroll
        for (int ai = 0; ai < 2; ++ai)
#pragma unroll
            for (int m = 0; m < 4; ++m) {
                f32x4 v[2][2];
#pragma unroll
                for (int bj = 0; bj < 2; ++bj)
#pragma unroll
                    for (int n = 0; n < 2; ++n) v[bj][n] = acc[ai][bj][m][n];
                if (donorm) {
                    float ss = 0.f;
#pragma unroll
                    for (int bj = 0; bj < 2; ++bj)
#pragma unroll
                        for (int n = 0; n < 2; ++n) ss += (v[bj][n][0] * v[bj][n][0] + v[bj][n][1] * v[bj][n][1]) + (v[bj][n][2] * v[bj][n][2] + v[bj][n][3] * v[bj][n][3]);
                    ss = lane_xor_add<16>(ss); ss = lane_xor_add<32>(ss);
                    const float rs = 1.0f / sqrtf(ss * (1.0f / 64.0f) + 1e-6f);
#pragma unroll
                    for (int bj = 0; bj < 2; ++bj)
#pragma unroll
                        for (int n = 0; n < 2; ++n) v[bj][n] = v[bj][n] * rs * gv[bj][n];
                }
                if (dorope) {
                    const int tl = tl0 + ai * 128 + m * 16; const float fp = (float)(fq >= 2 ? (tl & 63) : (tl >> 6));
#pragma unroll
                    for (int n = 0; n < 2; ++n) {
                        f32x4 cc, sn;
#pragma unroll
                        for (int j = 0; j < 4; ++j) { const float rev = __builtin_amdgcn_fractf(fp * rf[n][j]); cc[j] = __builtin_amdgcn_cosf(rev); sn[j] = __builtin_amdgcn_sinf(rev); }
                        const f32x4 x1 = v[0][n], x2 = v[1][n];
                        v[0][n] = x1 * cc - x2 * sn; v[1][n] = x2 * cc + x1 * sn;
                    }
                }
#pragma unroll
                for (int bj = 0; bj < 2; ++bj) {
                    const f32x4 v0 = v[bj][0] * qs, v1 = v[bj][1] * qs;
                    u32x4 w; w.x = cvt_pk_bf16(v0[0], v0[1]); w.y = cvt_pk_bf16(v0[2], v0[3]); w.z = cvt_pk_bf16(v1[0], v1[1]); w.w = cvt_pk_bf16(v1[2], v1[3]);
                    *(u32x4*)(orow0 + (size_t)(ai * 128 + m * 16) * 1280 + 32 * bj) = w;
                }
            }
    }
};

struct EpiFourier {
    static constexpr bool PERM = true, AFTER_DRAIN = false;
    bf16_t* O; int mode; float scale;
    __device__ __forceinline__ void operator()(const f32x4 (&acc)[2][2][4][2], const Unit& u, int wr, int wc, int fr, int fq) const {
        const size_t row0 = mode ? (size_t)(u.pn >> 5) * 8448 + 256 + (u.pn & 31) : (size_t)u.pn * 8448; const int rstride = mode ? 32 : 1;
        bf16_t* base = O + row0 * 1024 + 384 + wc * 32 + 8 * fq;
#pragma unroll
        for (int ai = 0; ai < 2; ++ai)
#pragma unroll
            for (int m = 0; m < 4; ++m) { bf16_t* rowp = base + (size_t)((ai * 128 + wr * 64 + m * 16 + fr) * rstride) * 1024;
#pragma unroll
                for (int bj = 0; bj < 2; ++bj) { const f32x4 v0 = acc[ai][bj][m][0] * scale, v1 = acc[ai][bj][m][1] * scale;
                    u32x4 w; w.x = cvt_pk_bf16(v0[0], v0[1]); w.y = cvt_pk_bf16(v0[2], v0[3]); w.z = cvt_pk_bf16(v1[0], v1[1]); w.w = cvt_pk_bf16(v1[2], v1[3]);
                    *(u32x4*)(rowp + bj * 128) = w; } }
    }
};

struct EpiResid {
    static constexpr bool PERM = true, AFTER_DRAIN = false;
    const float* xin; const float* cin;
    bf16_t* X; const float* gate;
    __device__ __forceinline__ void operator()(const f32x4 (&acc)[2][2][4][2], const Unit& u, int wr, int wc, int fr, int fq) const {
        const int b = u.pm / BR_TILES, pt = u.pm % BR_TILES; const bool is_ctx = (pt == 0);
        const float* gp = gate + (size_t)(is_ctx ? 8 : b) * 6 * 1024;
        const int col0 = u.pn * 256 + wc * 32 + 8 * fq, rloc = wr * 64 + fr;
        f32x4 gv[2][2];
#pragma unroll
        for (int bj = 0; bj < 2; ++bj)
#pragma unroll
            for (int n = 0; n < 2; ++n) gv[bj][n] = *(const f32x4*)(gp + col0 + bj * 128 + 4 * n);
        const float* rf = xin ? (is_ctx ? cin + (size_t)(b * 256 + rloc) * 1024 : xin + (size_t)(b * 8192 + (pt - 1) * 256 + rloc) * 1024) : nullptr;
        bf16_t* xb = X + (size_t)(u.pm * 256 + rloc) * 1024;
        if (rf) {
#pragma unroll
            for (int am = 0; am < 4; ++am) { const int ai = am >> 1, mb = (am & 1) * 2;
                f32x4 r0[4][2], r1[4][2];
#pragma unroll
                for (int m = mb; m < mb + 2; ++m)
#pragma unroll
                    for (int bj = 0; bj < 2; ++bj) { const size_t ro = (size_t)(ai * 128 + m * 16) * 1024 + col0 + bj * 128; r0[m][bj] = *(const f32x4*)(rf + ro); r1[m][bj] = *(const f32x4*)(rf + ro + 4); }
                asm volatile("" ::: "memory");
#pragma unroll
                for (int m = mb; m < mb + 2; ++m)
#pragma unroll
                    for (int bj = 0; bj < 2; ++bj) { const size_t ro = (size_t)(ai * 128 + m * 16) * 1024 + col0 + bj * 128;
                        const f32x4 o0 = r0[m][bj] + gv[bj][0] * acc[ai][bj][m][0], o1 = r1[m][bj] + gv[bj][1] * acc[ai][bj][m][1];
                        u32x4 w; w.x = cvt_pk_bf16(o0[0], o0[1]); w.y = cvt_pk_bf16(o0[2], o0[3]); w.z = cvt_pk_bf16(o1[0], o1[1]); w.w = cvt_pk_bf16(o1[2], o1[3]);
                        *(u32x4*)(xb + ro) = w; }
            }
        } else {
#pragma unroll
            for (int ai = 0; ai < 2; ++ai) {
            u32x4 rw[2][4][2];
#pragma unroll
                for (int m = 0; m < 4; ++m)
#pragma unroll
                    for (int bj = 0; bj < 2; ++bj) rw[ai][m][bj] = *(const u32x4*)(xb + (size_t)(ai * 128 + m * 16) * 1024 + col0 + bj * 128);
            asm volatile("" ::: "memory");
#pragma unroll
                for (int m = 0; m < 4; ++m)
#pragma unroll
                    for (int bj = 0; bj < 2; ++bj) { const u32x4 w_ = rw[ai][m][bj];
                        const f32x4 r0 = (f32x4){__uint_as_float(w_.x << 16), __uint_as_float(w_.x & 0xffff0000u), __uint_as_float(w_.y << 16), __uint_as_float(w_.y & 0xffff0000u)};
                        const f32x4 r1 = (f32x4){__uint_as_float(w_.z << 16), __uint_as_float(w_.z & 0xffff0000u), __uint_as_float(w_.w << 16), __uint_as_float(w_.w & 0xffff0000u)};
                        const f32x4 o0 = r0 + gv[bj][0] * acc[ai][bj][m][0], o1 = r1 + gv[bj][1] * acc[ai][bj][m][1];
                        u32x4 w; w.x = cvt_pk_bf16(o0[0], o0[1]); w.y = cvt_pk_bf16(o0[2], o0[3]); w.z = cvt_pk_bf16(o1[0], o1[1]); w.w = cvt_pk_bf16(o1[2], o1[3]);
                        *(u32x4*)(xb + (size_t)(ai * 128 + m * 16) * 1024 + col0 + bj * 128) = w; }
            }
        }
    }
};

struct EpiSwiglu {
    static constexpr bool PERM = true, AFTER_DRAIN = false;
    bf16_t* G;
    __device__ __forceinline__ void operator()(const f32x4 (&acc)[2][2][4][2], const Unit& u, int wr, int wc, int fr, int fq) const {
        bf16_t* base = G + (size_t)(u.pm * 256 + wr * 64 + fr) * 2816 + u.pn * 128 + wc * 32 + 8 * fq;
#pragma unroll
        for (int ai = 0; ai < 2; ++ai)
#pragma unroll
            for (int m = 0; m < 4; ++m) { f32x4 o[2];
#pragma unroll
                for (int n = 0; n < 2; ++n) { const f32x4 g = acc[ai][0][m][n], up = acc[ai][1][m][n];
#pragma unroll
                    for (int j = 0; j < 4; ++j) o[n][j] = g[j] * __builtin_amdgcn_rcpf(1.0f + __builtin_amdgcn_exp2f(-1.4426950408889634f * g[j])) * up[j]; }
                u32x4 w; w.x = cvt_pk_bf16(o[0][0], o[0][1]); w.y = cvt_pk_bf16(o[0][2], o[0][3]); w.z = cvt_pk_bf16(o[1][0], o[1][1]); w.w = cvt_pk_bf16(o[1][2], o[1][3]);
                *(u32x4*)(base + (size_t)(ai * 128 + m * 16) * 2816) = w; }
    }
};

template <class Epi, class Sched, bool ALIGN_EPI = false, bool SP2 = false>
__device__ __forceinline__ void gemm_phase(PG8_LAS unsigned char* lds, const Gemm g, const Sched& S, const Epi& E) {
    int tid_o = threadIdx.x; asm volatile("" : "+v"(tid_o));
    const int tid = tid_o, wid = __builtin_amdgcn_readfirstlane(tid >> 6), lane = tid & 63, wr = wid >> 2, wc = wid & 3, fr = lane & 15, fq = lane >> 4;
    const int K = g.K, nt = K / BK;
    unsigned voffA[2], voffB[2];
#pragma unroll
    for (int i = 0; i < 2; ++i) { int R, C; stage_rc(tid * 16 + i * 8192, R, C); const int Rb = Epi::PERM ? ((R & ~31) + perm32(R & 31)) : R;
        voffA[i] = (unsigned)(R * K + C) * 2u; voffB[i] = (unsigned)(Rb * K + C) * 2u; }
    const size_t kstep = (size_t)(BK * 2);
    const size_t hstep = (size_t)HALF * K * 2;
    const size_t tstep = 2 * hstep;
    const unsigned ldsw = (unsigned)wid * 1024u;
    const int aoff = lds_byte(wr * 64 + fr, fq * 8), boff = lds_byte(wc * 32 + fr, fq * 8);
#define PG8_SA(b, h) (((b) * 2 + (h)) * HTB)
#define PG8_SB(b, h) ((4 + (b) * 2 + (h)) * HTB)
#define PG8_STAGE(bufoff, gbase, voff) do { _Pragma("unroll") for (int _i = 0; _i < 2; ++_i) \
        __builtin_amdgcn_global_load_lds((const unsigned*)((const char*)(gbase) + (voff)[_i]), (PG8_LAS unsigned*)(lds + (bufoff) + ldsw + _i * 8192), 16, 0, 0); } while (0)
#define PG8_LDA(dst, b, h) do { _Pragma("unroll") for (int m = 0; m < 4; ++m) _Pragma("unroll") for (int k = 0; k < 2; ++k) dst[m][k] = *(const PG8_LAS bf16x8*)(lds + PG8_SA(b, h) + aoff + m * 2048 + k * 1024); } while (0)
#define PG8_LDB(dst, b, h) do { _Pragma("unroll") for (int n = 0; n < 2; ++n) _Pragma("unroll") for (int k = 0; k < 2; ++k) dst[n][k] = *(const PG8_LAS bf16x8*)(lds + PG8_SB(b, h) + boff + n * 2048 + k * 1024); } while (0)
#define PG8_MMA(ai, bj, At, Bt) do { __builtin_amdgcn_s_setprio(1); _Pragma("unroll") for (int m = 0; m < 4; ++m) _Pragma("unroll") for (int n = 0; n < 2; ++n) _Pragma("unroll") for (int k = 0; k < 2; ++k) \
        acc[ai][bj][m][n] = __builtin_amdgcn_mfma_f32_16x16x32_bf16(Bt[n][k], At[m][k], acc[ai][bj][m][n], 0, 0, 0); __builtin_amdgcn_s_setprio(0); } while (0)
#define PG8_WAIT_V(n) asm volatile("s_waitcnt vmcnt(" #n ")" ::: "memory")
#define PG8_WAIT_L(n) asm volatile("s_waitcnt lgkmcnt(" #n ")" ::: "memory")
#define PG8_BAR __builtin_amdgcn_s_barrier()
#define PG8_SCHED __builtin_amdgcn_sched_barrier(0)
    Unit cur, nxt; int ui = 0;
    if (!S.next(0, cur)) return;
    f32x4 acc[2][2][4][2];
#pragma unroll
    for (int a = 0; a < 2; ++a)
#pragma unroll
        for (int b = 0; b < 2; ++b)
#pragma unroll
            for (int m = 0; m < 4; ++m)
#pragma unroll
                for (int n = 0; n < 2; ++n) acc[a][b][m][n] = (f32x4){0.f, 0.f, 0.f, 0.f};
    bf16x8 At[4][2], B0[2][2], B1[2][2];
    const char* cA = (const char*)g.A + (size_t)cur.pm * tstep; const char* cB = (const char*)g.Bt + (size_t)cur.pn * tstep;
    S.a_ready(cur);
    if constexpr (SP2) {
        PG8_STAGE(PG8_SB(0, 0), cB, voffB); PG8_STAGE(PG8_SB(0, 1), cB + hstep, voffB); PG8_STAGE(PG8_SA(0, 0), cA, voffA); PG8_STAGE(PG8_SA(0, 1), cA + hstep, voffA);
        if (wr == 1) PG8_BAR;
        PG8_WAIT_V(2); PG8_BAR;
        PG8_STAGE(PG8_SB(1, 0), cB + kstep, voffB); PG8_STAGE(PG8_SA(1, 0), cA + kstep, voffA); PG8_STAGE(PG8_SB(1, 1), cB + hstep + kstep, voffB);
        PG8_WAIT_V(6); PG8_BAR;
    } else {
        PG8_STAGE(PG8_SB(0, 0), cB, voffB); PG8_STAGE(PG8_SA(0, 0), cA, voffA); PG8_STAGE(PG8_SB(0, 1), cB + hstep, voffB); PG8_STAGE(PG8_SA(0, 1), cA + hstep, voffA);
        if (wr == 1) PG8_BAR;
        PG8_WAIT_V(4); PG8_BAR;
        PG8_STAGE(PG8_SB(1, 0), cB + kstep, voffB); PG8_STAGE(PG8_SA(1, 0), cA + kstep, voffA); PG8_STAGE(PG8_SB(1, 1), cB + hstep + kstep, voffB);
        PG8_WAIT_V(6); PG8_BAR;
    }
    for (;;) {
        const bool has_next = S.next(ui + 1, nxt);
        const char* nA = has_next ? (const char*)g.A + (size_t)nxt.pm * tstep : cA; const char* nB = has_next ? (const char*)g.Bt + (size_t)nxt.pn * tstep : cB;
        for (int t = 0; t < nt; t += 2) {
            const bool last = (t == nt - 2);
            const char* a1 = cA + (size_t)(t + 1) * kstep;
            const char* a2 = last ? nA : cA + (size_t)(t + 2) * kstep; const char* b2 = last ? nB : cB + (size_t)(t + 2) * kstep;
            const char* a3 = a2 + kstep; const char* b3 = b2 + kstep;
            if (last && has_next) S.a_ready(nxt);
            if constexpr (SP2) {
            PG8_LDB(B0, 0, 0); PG8_LDB(B1, 0, 1); PG8_SCHED; PG8_LDA(At, 0, 0); PG8_STAGE(PG8_SA(1, 1), a1 + hstep, voffA);
            PG8_WAIT_V(8); PG8_WAIT_L(0); PG8_BAR; PG8_MMA(0, 0, At, B0); PG8_MMA(0, 1, At, B1); PG8_BAR; PG8_SCHED;
            PG8_LDA(At, 0, 1); PG8_STAGE(PG8_SB(0, 0), b2, voffB); PG8_STAGE(PG8_SB(0, 1), b2 + hstep, voffB); PG8_STAGE(PG8_SA(0, 0), a2, voffA);
            PG8_WAIT_V(8); PG8_WAIT_L(0); PG8_BAR; PG8_MMA(1, 0, At, B0); PG8_MMA(1, 1, At, B1); PG8_BAR; PG8_SCHED;
            PG8_LDB(B0, 1, 0); PG8_LDB(B1, 1, 1); PG8_SCHED; PG8_LDA(At, 1, 0); PG8_STAGE(PG8_SA(0, 1), a2 + hstep, voffA);
            PG8_WAIT_V(8); PG8_WAIT_L(0); PG8_BAR; PG8_MMA(0, 0, At, B0); PG8_MMA(0, 1, At, B1); PG8_BAR; PG8_SCHED;
            PG8_LDA(At, 1, 1); PG8_STAGE(PG8_SB(1, 0), b3, voffB); PG8_STAGE(PG8_SB(1, 1), b3 + hstep, voffB); PG8_STAGE(PG8_SA(1, 0), a3, voffA);
            PG8_WAIT_V(8); PG8_WAIT_L(0); PG8_BAR; PG8_MMA(1, 0, At, B0); PG8_MMA(1, 1, At, B1); PG8_BAR; PG8_SCHED;
            } else {
            PG8_LDB(B0, 0, 0); PG8_SCHED; PG8_LDA(At, 0, 0); PG8_STAGE(PG8_SA(1, 1), a1 + hstep, voffA);
            PG8_WAIT_L(8); PG8_BAR; PG8_WAIT_L(0); PG8_MMA(0, 0, At, B0); PG8_BAR; PG8_SCHED;
            PG8_LDB(B1, 0, 1); PG8_STAGE(PG8_SB(0, 0), b2, voffB);
            PG8_BAR; PG8_WAIT_L(0); PG8_MMA(0, 1, At, B1); PG8_BAR;
            PG8_LDA(At, 0, 1); PG8_STAGE(PG8_SA(0, 0), a2, voffA);
            PG8_BAR; PG8_WAIT_L(0); PG8_MMA(1, 0, At, B0); PG8_BAR; PG8_SCHED;
            PG8_STAGE(PG8_SB(0, 1), b2 + hstep, voffB);
            PG8_WAIT_V(6); PG8_BAR; PG8_MMA(1, 1, At, B1); PG8_BAR;
            PG8_LDB(B0, 1, 0); PG8_SCHED; PG8_LDA(At, 1, 0); PG8_STAGE(PG8_SA(0, 1), a2 + hstep, voffA);
            PG8_WAIT_L(8); PG8_BAR; PG8_WAIT_L(0); PG8_MMA(0, 0, At, B0); PG8_BAR; PG8_SCHED;
            PG8_LDB(B1, 1, 1); PG8_STAGE(PG8_SB(1, 0), b3, voffB);
            PG8_BAR; PG8_WAIT_L(0); PG8_MMA(0, 1, At, B1); PG8_BAR;
            PG8_LDA(At, 1, 1); PG8_STAGE(PG8_SA(1, 0), a3, voffA);
            PG8_BAR; PG8_WAIT_L(0); PG8_MMA(1, 0, At, B0); PG8_BAR; PG8_SCHED;
            PG8_STAGE(PG8_SB(1, 1), b3 + hstep, voffB);
            PG8_WAIT_V(6); PG8_BAR; PG8_MMA(1, 1, At, B1); PG8_BAR;
            }
        }
        if constexpr (ALIGN_EPI) { if (wr == 0) PG8_BAR; }
        if constexpr (!Epi::AFTER_DRAIN) { E(acc, cur, wr, wc, fr, fq); S.done(cur); }
        if (!has_next) break;
#pragma unroll
        for (int a = 0; a < 2; ++a)
#pragma unroll
            for (int b = 0; b < 2; ++b)
#pragma unroll
                for (int m = 0; m < 4; ++m)
#pragma unroll
                    for (int n = 0; n < 2; ++n) acc[a][b][m][n] = (f32x4){0.f, 0.f, 0.f, 0.f};
        cur = nxt; cA = nA; cB = nB; ++ui;
        if constexpr (ALIGN_EPI) { if (wr == 1) PG8_BAR; }
    }
    PG8_WAIT_V(0);
    if constexpr (!ALIGN_EPI) { if (wr == 0) PG8_BAR; }
    PG8_BAR;
    if constexpr (Epi::AFTER_DRAIN) { E.fused(acc, cur, wr, wc, fr, fq, lds, wid, lane); S.done(cur); }
#undef PG8_SA
#undef PG8_SB
#undef PG8_STAGE
#undef PG8_LDA
#undef PG8_LDB
#undef PG8_MMA
#undef PG8_WAIT_V
#undef PG8_WAIT_L
#undef PG8_BAR
#undef PG8_SCHED
}
}
namespace attn_body {
using bf16=__hip_bfloat16;
using bf16x8=__attribute__((ext_vector_type(8)))short;
using s16x4=__attribute__((ext_vector_type(4)))short;
using f32x16=__attribute__((ext_vector_type(16)))float;
using u32x4=__attribute__((ext_vector_type(4)))unsigned;
constexpr int D=64,PQ=1280,PO=1024;
constexpr int NW=8,QBLK=32,QB=QBLK*NW,KVBLK=64;
constexpr int ATTN_UNIT_ROWS=QB;
__device__ __forceinline__ int crow(int r,int hi){return (r&3)+8*(r>>2)+4*hi;}
#define SBAR() __builtin_amdgcn_sched_barrier(0)
__device__ __forceinline__ void wmask(f32x16&p0,f32x16&p1,int dl,int hi){
  const float NEG=-INFINITY; const int kb=4*hi;
  #pragma unroll
  for(int r=0;r<16;++r){int kv=kb+(r&3)+8*(r>>2); if((unsigned)(dl-kv+128)>256u)p0[r]=NEG; if((unsigned)(dl-kv-32+128)>256u)p1[r]=NEG;}
}

constexpr int NSLOT=3, SLOTB=8192;
constexpr int LDS_K=0, LDS_V=NSLOT*SLOTB, LDS_WS=2*NSLOT*SLOTB, LDS_OST=LDS_WS+NW*64*4, LDS_BYTES=LDS_OST+NW*4096;
constexpr float C2=0.125f*1.4426950408889634f;
__device__ __forceinline__ void glds16(const void*gsrc,unsigned lds_dst){unsigned keep;
  asm volatile("s_mov_b32 %0, m0\n\ts_mov_b32 m0, %2\n\ts_nop 0\n\tglobal_load_lds_dwordx4 %1, off\n\ts_mov_b32 m0, %0":"=&s"(keep):"v"(gsrc),"s"(lds_dst):"memory");}
__device__ __forceinline__ float max3f(float a,float b,float c){float r;asm("v_max3_f32 %0, %1, %2, %3":"=v"(r):"v"(a),"v"(b),"v"(c));return r;}
__device__ __forceinline__ float max2f(float a,float b){float r;asm("v_max_f32_e32 %0, %1, %2":"=v"(r):"v"(a),"v"(b));return r;}
__device__ __forceinline__ float fadd_s(float a,float b){float r;asm("v_add_f32_e32 %0, %1, %2":"=v"(r):"v"(a),"v"(b));return r;}
__device__ __forceinline__ float fsub_s(float a,float b){float r;asm("v_sub_f32_e32 %0, %1, %2":"=v"(r):"v"(a),"v"(b));return r;}
typedef float f32x2_t __attribute__((ext_vector_type(2))); typedef __bf16 bf16x2_t __attribute__((ext_vector_type(2)));
__device__ __forceinline__ unsigned cvtpk_s(float lo,float hi){f32x2_t v={lo,hi};bf16x2_t b=__builtin_convertvector(v,bf16x2_t);return __builtin_bit_cast(unsigned,b);}
#define WAIT_BAR(N) asm volatile("s_waitcnt vmcnt(" #N ") lgkmcnt(0)\n\ts_barrier":::"memory")

__device__ __forceinline__ void qkt(f32x16&p0,f32x16&p1,const char*Kslot,const bf16x8*qr,const f32x16&negm,int r32,int hi){
  const char*kb=Kslot+hi*1024+r32*16;
  #pragma unroll
  for(int d0=0;d0<4;++d0){
    const bf16x8 b0=*reinterpret_cast<const bf16x8*>(kb+d0*2048);
    const bf16x8 b1=*reinterpret_cast<const bf16x8*>(kb+d0*2048+512);
    if(d0==0){p0=__builtin_amdgcn_mfma_f32_32x32x16_bf16(b0,qr[0],negm,0,0,0);p1=__builtin_amdgcn_mfma_f32_32x32x16_bf16(b1,qr[0],negm,0,0,0);}
    else{p0=__builtin_amdgcn_mfma_f32_32x32x16_bf16(b0,qr[d0],p0,0,0,0);p1=__builtin_amdgcn_mfma_f32_32x32x16_bf16(b1,qr[d0],p1,0,0,0);}}
}
typedef __attribute__((address_space(3))) const char* lds_cptr;
typedef short v4i16_t __attribute__((ext_vector_type(4)));
__device__ __forceinline__ void kload8(bf16x8*kf,lds_cptr kp){
  kf[0]=*(const __attribute__((address_space(3))) bf16x8*)(kp);      kf[1]=*(const __attribute__((address_space(3))) bf16x8*)(kp+512);
  kf[2]=*(const __attribute__((address_space(3))) bf16x8*)(kp+2048); kf[3]=*(const __attribute__((address_space(3))) bf16x8*)(kp+2560);
  kf[4]=*(const __attribute__((address_space(3))) bf16x8*)(kp+4096); kf[5]=*(const __attribute__((address_space(3))) bf16x8*)(kp+4608);
  kf[6]=*(const __attribute__((address_space(3))) bf16x8*)(kp+6144); kf[7]=*(const __attribute__((address_space(3))) bf16x8*)(kp+6656);
}
__device__ __forceinline__ void kload2(bf16x8*kf,lds_cptr kp,int j){ kf[2*j]=*(const __attribute__((address_space(3))) bf16x8*)(kp+j*2048); kf[2*j+1]=*(const __attribute__((address_space(3))) bf16x8*)(kp+j*2048+512); }
__device__ __forceinline__ s16x4 vtr(lds_cptr p){ return __builtin_bit_cast(s16x4,__builtin_amdgcn_ds_read_tr16_b64_v4i16((__attribute__((address_space(3))) v4i16_t*)p)); }
__device__ __forceinline__ float rowmax(const f32x16&p0,const f32x16&p1){
  float a=max3f(p0[0],p0[1],p1[0]),b=max3f(p0[2],p0[3],p1[1]);a=max3f(a,p1[2],p1[3]);
  #pragma unroll
  for(int r=4;r<16;r+=4){a=max3f(a,p0[r],p0[r+1]);b=max3f(b,p0[r+2],p0[r+3]);a=max3f(a,p1[r],p1[r+1]);b=max3f(b,p1[r+2],p1[r+3]);}
  const float m=max2f(a,b);
  auto rr=__builtin_amdgcn_permlane32_swap(__float_as_uint(m),__float_as_uint(m),false,false);
  return max2f(__uint_as_float(rr[0]),__uint_as_float(rr[1]));
}
__device__ __forceinline__ void pv(f32x16*o,int vb,bf16x8 pa0,bf16x8 pa1,bf16x8 pa2,bf16x8 pa3){
  #pragma unroll
  for(int d0=0;d0<2;++d0){s16x4 lo[4],hi[4];
    #pragma unroll
    for(int ks=0;ks<4;++ks){
      asm volatile("ds_read_b64_tr_b16 %0,%1 offset:%c2":"=&v"(lo[ks]):"v"(vb),"i"(d0*4096+ks*1024):"memory");
      asm volatile("ds_read_b64_tr_b16 %0,%1 offset:%c2":"=&v"(hi[ks]):"v"(vb),"i"(d0*4096+ks*1024+512):"memory");}
    asm volatile("s_waitcnt lgkmcnt(0)":::"memory");SBAR();
    #define PK(k) (bf16x8){lo[k][0],lo[k][1],lo[k][2],lo[k][3],hi[k][0],hi[k][1],hi[k][2],hi[k][3]}
    o[d0]=__builtin_amdgcn_mfma_f32_32x32x16_bf16(pa0,PK(0),o[d0],0,0,0);
    o[d0]=__builtin_amdgcn_mfma_f32_32x32x16_bf16(pa1,PK(1),o[d0],0,0,0);
    o[d0]=__builtin_amdgcn_mfma_f32_32x32x16_bf16(pa2,PK(2),o[d0],0,0,0);
    o[d0]=__builtin_amdgcn_mfma_f32_32x32x16_bf16(pa3,PK(3),o[d0],0,0,0);
    #undef PK
  }
}

#ifndef ATTN_STORE16
#define ATTN_STORE16(p,v) (*(u32x4*)(p)=(v))
#endif
template<int THRL,bool WIN,bool FIXM> __device__ __forceinline__ void attn_unit(const bf16*Qu,const bf16*__restrict__ Kh,const bf16*__restrict__ Vh,bf16*Ou,const int NT,const int boff,const int dq,const float sink_l2,const float mfix,char*shm){
  int tid_o=threadIdx.x; asm volatile("":"+v"(tid_o));
  const int tid=tid_o,lane=tid&63,r32=lane&31,hi=lane>>5; const int wid=__builtin_amdgcn_readfirstlane(tid>>6);
  const bf16*Qw=Qu+(long)(wid*QBLK)*PQ;
  const unsigned lds0=(unsigned)(uintptr_t)shm;
  float*wsf=(float*)(shm+LDS_WS)+wid*64;
  const bf16*ksrc=Kh+(long)lane*PQ+wid*8;
  const bf16*vsrc=Vh+(long)(16*(wid&3)+(lane>>2))*PQ+(wid>>2)*32+(lane&3)*8;
  const unsigned kdst=lds0+LDS_K+wid*1024, vdst=lds0+LDS_V+wid*1024;
  #define TROW(t) ((long)(KVBLK*(t)+((WIN&&(t)>=4)?boff:0)))
  #define DMA_K(t,slot) glds16(ksrc+TROW(t)*PQ,(unsigned)__builtin_amdgcn_readfirstlane(kdst+(slot)))
  #define DMA_V(t,slot) glds16(vsrc+TROW(t)*PQ,(unsigned)__builtin_amdgcn_readfirstlane(vdst+(slot)))
  const int vb0=(int)(lds0+LDS_V)+((lane>>4)&1)*32+(lane&3)*8+(4*hi+((lane&15)>>2))*64;
  const char*Kbase=shm+LDS_K; bf16x8 kf[8];
  const lds_cptr shm3=(lds_cptr)shm; const lds_cptr kp0=shm3+LDS_K+hi*1024+r32*16; const lds_cptr vp0=shm3+LDS_V+((lane>>4)&1)*32+(lane&3)*8+(4*hi+((lane&15)>>2))*64;
  DMA_K(0,0);DMA_V(0,0);DMA_K(1,SLOTB);
  bf16x8 qr[4];
  #pragma unroll
  for(int d0=0;d0<4;++d0)qr[d0]=*reinterpret_cast<const bf16x8*>(&Qw[(long)r32*PQ+d0*16+hi*8]);
  float mhat=FIXM?mfix:0.f,l_reg=0.f;asm volatile("":"+v"(mhat));
  f32x16 o[2];{float z_=0.f;asm volatile("":"+v"(z_));
  _Pragma("unroll") for(int r=0;r<16;++r){o[0][r]=z_;o[1][r]=z_;}}f32x16 negm;
  #pragma unroll
  for(int r=0;r<16;++r)negm[r]=-mhat;
  asm volatile("":"+v"(negm));
  const int dqrel=dq+wid*QBLK+r32;
  #define CMASK(P0,P1,t) do{ if(WIN){ if((t)>=4){ const int wb_=dq+wid*QBLK-KVBLK*((t)-4);     \
      if(wb_>97||wb_<-65) wmask(P0,P1,dqrel-KVBLK*((t)-4),hi); } } }while(0)
  bool resc=false;
  #define START(P0,P1) do{ resc=false; \
    if(!FIXM){ const float rm=rowmax(P0,P1); const float dl=rm; mhat=fadd_s(mhat,dl); \
      _Pragma("unroll") for(int r=0;r<16;++r){P0[r]=fsub_s(P0[r],dl);P1[r]=fsub_s(P1[r],dl);} \
      _Pragma("unroll") for(int r=0;r<16;++r)negm[r]=-mhat; asm volatile("":"+v"(negm)); } \
    _Pragma("unroll") for(int r=0;r<16;++r)P0[r]=__builtin_amdgcn_exp2f(P0[r]); }while(0)
  #define RESC() do{ if(resc){ asm volatile("s_waitcnt lgkmcnt(0)":::"memory"); \
      _Pragma("unroll") for(int d_=0;d_<2;++d_) _Pragma("unroll") for(int r=0;r<16;++r)o[d_][r]*=wsf[crow(r,hi)]; } }while(0)
  f32x16 pA0,pA1,pB0,pB1;
  int sl_prev=0,sl_cur=0,sl_next=SLOTB;
  #define ROT() do{sl_prev=sl_cur;sl_cur=sl_next;sl_next=(sl_next==(NSLOT-1)*SLOTB)?0:sl_next+SLOTB;}while(0)
  DMA_K(2,2*SLOTB);
  WAIT_BAR(3);
  qkt(pA0,pA1,Kbase,qr,negm,r32,hi);asm volatile("s_nop 15\n\ts_nop 7":"+v"(pA0),"+v"(pA1));CMASK(pA0,pA1,0);
  START(pA0,pA1);
  _Pragma("unroll") for(int r=0;r<16;++r)pA1[r]=__builtin_amdgcn_exp2f(pA1[r]);
  WAIT_BAR(0);
  DMA_K(3,0);DMA_V(1,SLOTB);
  ROT();
  kload8(kf,kp0+sl_cur);
  WAIT_BAR(2);
  s16x4 vlo[8],vhi[8]; u32x4 pw0,pw1,pw2,pw3;
  #define PKW(P,B) cvtpk_s(P[B],P[B+1])
  #define PAF(k) __builtin_bit_cast(bf16x8,pw##k)
  #define VFR(i) (bf16x8){vlo[i][0],vlo[i][1],vlo[i][2],vlo[i][3],vhi[i][0],vhi[i][1],vhi[i][2],vhi[i][3]}
  #define PIN(x) asm volatile("":"+v"(x))
  #define MX3(a,b,c) __builtin_fmaxf(__builtin_fmaxf((a),(b)),(c))
  #define GAPA(MF,A0,A1,A2,A3,W0,W1,PW) do{ MF; sacc+=A0; sacc+=A1; sacc+=A2; sacc+=A3; PIN(sacc); W0; W1; PIN(PW); SBAR(); }while(0)
  #define EX(v) __builtin_amdgcn_exp2f(v)
  #define GAPB(MF,X,B) do{ MF; X[B]=EX(X[B]); X[B+1]=EX(X[B+1]); X[B+2]=EX(X[B+2]); X[B+3]=EX(X[B+3]); PIN(X); SBAR(); }while(0)
  #define VRD(i) do{ vlo[i]=vtr(vp_+(((i)>>2)*4096+((i)&3)*1024)); vhi[i]=vtr(vp_+(((i)>>2)*4096+((i)&3)*1024+512)); }while(0)
  #define KRD(G,j) do{ if(G){ kload2(kf,kp0+sl_next,j); SBAR(); } }while(0)
  #define STEP(C0,C1,P0,P1,t,GK,GV,GL) do{ SBAR(); \
    const lds_cptr vp_=vp0+sl_prev; \
    VRD(0); SBAR(); float sacc=(P0[0]+P0[1]); \
    GAPA(C0=__builtin_amdgcn_mfma_f32_32x32x16_bf16(kf[0],qr[0],negm,0,0,0), P0[2],P0[3],P0[4],P0[5],     pw0[0]=PKW(P0,0), pw0[1]=PKW(P0,2), pw0); \
    VRD(4); SBAR(); GAPA(C1=__builtin_amdgcn_mfma_f32_32x32x16_bf16(kf[1],qr[0],negm,0,0,0), P0[6],P0[7],P0[8],P0[9],     pw0[2]=PKW(P0,4), pw0[3]=PKW(P0,6), pw0); \
    VRD(1); SBAR(); GAPA(C0=__builtin_amdgcn_mfma_f32_32x32x16_bf16(kf[2],qr[1],C0,0,0,0),   P0[10],P0[11],P0[12],P0[13], pw1[0]=PKW(P0,8), pw1[1]=PKW(P0,10), pw1); \
    VRD(5); SBAR(); GAPA(C1=__builtin_amdgcn_mfma_f32_32x32x16_bf16(kf[3],qr[1],C1,0,0,0),   P0[14],P0[15],P1[0],P1[1],   pw1[2]=PKW(P0,12),pw1[3]=PKW(P0,14), pw1); \
    VRD(2); SBAR(); GAPA(C0=__builtin_amdgcn_mfma_f32_32x32x16_bf16(kf[4],qr[2],C0,0,0,0),   P1[2],P1[3],P1[4],P1[5],     pw2[0]=PKW(P1,0), pw2[1]=PKW(P1,2), pw2); \
    VRD(6); SBAR(); GAPA(C1=__builtin_amdgcn_mfma_f32_32x32x16_bf16(kf[5],qr[2],C1,0,0,0),   P1[6],P1[7],P1[8],P1[9],     pw2[2]=PKW(P1,4), pw2[3]=PKW(P1,6), pw2); \
    VRD(3); SBAR(); GAPA(C0=__builtin_amdgcn_mfma_f32_32x32x16_bf16(kf[6],qr[3],C0,0,0,0),   P1[10],P1[11],P1[12],P1[13], pw3[0]=PKW(P1,8), pw3[1]=PKW(P1,10), pw3); \
    VRD(7); SBAR(); GAPA(C1=__builtin_amdgcn_mfma_f32_32x32x16_bf16(kf[7],qr[3],C1,0,0,0),   P1[14],P1[15],0.f,0.f,       pw3[2]=PKW(P1,12),pw3[3]=PKW(P1,14), pw3); \
    l_reg+=sacc; \
    if(GK){DMA_K((t)+3,sl_cur);} if(GV){DMA_V((t)+1,sl_next);} \
    CMASK(C0,C1,t); \
    if(!FIXM){ float a=MX3(C0[0],C0[1],C1[0]),b=MX3(C0[2],C0[3],C1[1]); a=MX3(a,C1[2],C1[3]); \
      _Pragma("unroll") for(int r=4;r<16;r+=4){a=MX3(a,C0[r],C0[r+1]);b=MX3(b,C0[r+2],C0[r+3]);a=MX3(a,C1[r],C1[r+1]);b=MX3(b,C1[r+2],C1[r+3]);} \
      float rm=__builtin_fmaxf(a,b); { auto rr=__builtin_amdgcn_permlane32_swap(__float_as_uint(rm),__float_as_uint(rm),false,false); rm=__builtin_fmaxf(__uint_as_float(rr[0]),__uint_as_float(rr[1])); } \
      resc=false; \
      if(__builtin_expect(__any(rm>(float)THRL),0)){ const float dl=__builtin_fmaxf(rm,0.f); mhat+=dl; \
        _Pragma("unroll") for(int r=0;r<16;++r){C0[r]-=dl;C1[r]-=dl;} \
        _Pragma("unroll") for(int r=0;r<16;++r)negm[r]=-mhat; asm volatile("":"+v"(negm)); \
        const float f=__builtin_amdgcn_exp2f(-dl); l_reg*=f; if(hi==0)wsf[r32]=f; resc=true; } } \
    SBAR(); \
    GAPB(o[0]=__builtin_amdgcn_mfma_f32_32x32x16_bf16(PAF(0),VFR(0),o[0],0,0,0), C0,0); \
    GAPB(o[1]=__builtin_amdgcn_mfma_f32_32x32x16_bf16(PAF(0),VFR(4),o[1],0,0,0), C0,4); \
    KRD(GL,0); GAPB(o[0]=__builtin_amdgcn_mfma_f32_32x32x16_bf16(PAF(1),VFR(1),o[0],0,0,0), C0,8); \
    KRD(GL,1); GAPB(o[1]=__builtin_amdgcn_mfma_f32_32x32x16_bf16(PAF(1),VFR(5),o[1],0,0,0), C0,12); \
    KRD(GL,2); GAPB(o[0]=__builtin_amdgcn_mfma_f32_32x32x16_bf16(PAF(2),VFR(2),o[0],0,0,0), C1,0); \
    KRD(GL,3); GAPB(o[1]=__builtin_amdgcn_mfma_f32_32x32x16_bf16(PAF(2),VFR(6),o[1],0,0,0), C1,4); \
    GAPB(o[0]=__builtin_amdgcn_mfma_f32_32x32x16_bf16(PAF(3),VFR(3),o[0],0,0,0), C1,8); \
    GAPB(o[1]=__builtin_amdgcn_mfma_f32_32x32x16_bf16(PAF(3),VFR(7),o[1],0,0,0), C1,12); \
    }while(0)
  int t=1;
  for(;t+5<NT;t+=2){
    STEP(pB0,pB1,pA0,pA1,t,true,true,true);     WAIT_BAR(2); RESC(); ROT();
    STEP(pA0,pA1,pB0,pB1,t+1,true,true,true);   WAIT_BAR(2); RESC(); ROT();
  }
  #define ENDW(tt) do{ if((tt)+3<NT){WAIT_BAR(2);} else if((tt)+2<NT){WAIT_BAR(1);} else {WAIT_BAR(0);} }while(0)
  for(;t+1<NT;t+=2){
    STEP(pB0,pB1,pA0,pA1,t,(t+3<NT),(t+1<NT),(t+1<NT));       ENDW(t);   RESC(); ROT();
    STEP(pA0,pA1,pB0,pB1,t+1,(t+4<NT),(t+2<NT),(t+2<NT));     ENDW(t+1); RESC(); ROT();
  }
  STEP(pB0,pB1,pA0,pA1,NT-1,false,false,false); RESC();
  { float sacc=pB0[0]+pB0[1]; _Pragma("unroll") for(int r=2;r<16;++r)sacc+=pB0[r]; _Pragma("unroll") for(int r=0;r<16;++r)sacc+=pB1[r]; l_reg+=sacc;
    pw0=(u32x4){PKW(pB0,0),PKW(pB0,2),PKW(pB0,4),PKW(pB0,6)};pw1=(u32x4){PKW(pB0,8),PKW(pB0,10),PKW(pB0,12),PKW(pB0,14)};pw2=(u32x4){PKW(pB1,0),PKW(pB1,2),PKW(pB1,4),PKW(pB1,6)};pw3=(u32x4){PKW(pB1,8),PKW(pB1,10),PKW(pB1,12),PKW(pB1,14)};
    SBAR(); pv(o,vb0+sl_cur,PAF(0),PAF(1),PAF(2),PAF(3)); }
  #undef PKW
  #undef PAF
  #undef VFR
  #undef PIN
  #undef MX3
  #undef GAPA
  #undef GAPB
  #undef EX
  #undef VRD
  #undef KRD
  #undef STEP
  #undef ENDW
  {auto rr=__builtin_amdgcn_permlane32_swap(__float_as_uint(l_reg),__float_as_uint(l_reg),false,false);l_reg=__uint_as_float(rr[0])+__uint_as_float(rr[1]);}
  l_reg+=__builtin_amdgcn_exp2f(sink_l2-mhat);
  if(hi==0)wsf[32+r32]=l_reg;asm volatile("s_waitcnt lgkmcnt(0)":::"memory");
  float rli[16];
  #pragma unroll
  for(int r=0;r<16;++r)rli[r]=__builtin_amdgcn_rcpf(wsf[32+crow(r,hi)]);
  bf16*Ow=Ou+(long)(wid*QBLK)*PO;
  { bf16*stg=(bf16*)(shm+LDS_OST)+wid*2048;
    #pragma unroll
    for(int r=0;r<16;++r){const int orow=crow(r,hi);
      #pragma unroll
      for(int d0=0;d0<2;++d0)stg[orow*64+d0*32+r32]=__float2bfloat16(o[d0][r]*rli[r]);}
    asm volatile("s_waitcnt lgkmcnt(0)":::"memory");
    #pragma unroll
    for(int i=0;i<4;++i){const int row=i*8+(lane>>3),ch=lane&7; const u32x4 v=*(const u32x4*)(stg+row*64+ch*8); ATTN_STORE16(Ow+(long)row*PO+ch*8,v);} }
  asm volatile("s_waitcnt lgkmcnt(0)\n\ts_barrier":::"memory");
  #undef TROW
  #undef DMA_K
  #undef DMA_V
  #undef CMASK
  #undef START
  #undef RESC
  #undef ROT
}
constexpr int ATTN_LDS_BYTES=LDS_BYTES;
#undef SBAR
#undef WAIT_BAR
}
namespace cg = cooperative_groups;
#define LAS __attribute__((address_space(3)))
typedef unsigned short u16;
typedef unsigned v4u __attribute__((ext_vector_type(4)));
typedef float f32x4 __attribute__((ext_vector_type(4)));
#define LDS_WAIT() asm volatile("s_waitcnt lgkmcnt(0)" ::: "memory")
#define XB_TMO      128
#define XB_XCNT(j)  (256  + 64 * (j))
#define XB_XSUB(j)  (1280 + 64 * (j))
#define XB_XGEN(j)  (2304 + 64 * (j))
#define XB_TOP      3328
#define XB_TOPGEN   3392
#define XCD_BAR_WORDS 3456
#define XB_SPIN_CAP (1u << 18)

__device__ __forceinline__ unsigned xb_ld(unsigned* p)              { return __hip_atomic_load(p, __ATOMIC_RELAXED, __HIP_MEMORY_SCOPE_AGENT); }
__device__ __forceinline__ unsigned xb_add(unsigned* p, unsigned v) { return __hip_atomic_fetch_add(p, v, __ATOMIC_RELAXED, __HIP_MEMORY_SCOPE_AGENT); }
__device__ __forceinline__ unsigned xb_xcc_id() { return (unsigned)__builtin_amdgcn_s_getreg((3 << 11) | 20) & 0xFu; }
#define XB_SPIN(cond, bar) do { unsigned _sp = 0; while (cond) { __builtin_amdgcn_s_sleep(1); \
    if ((++_sp & 255u) == 0u) { if (xb_ld(&(bar)[XB_TMO])) break; if (_sp > XB_SPIN_CAP) { atomicAdd(&(bar)[XB_TMO], 1u); break; } } } } while (0)

struct XcdBarrier {
    unsigned* bar; unsigned x;
    volatile LAS unsigned* st;
};

__device__ __forceinline__ XcdBarrier xcd_barrier_post(unsigned* bar, volatile LAS unsigned* st) {
    XcdBarrier b; b.bar = bar; b.x = xb_xcc_id(); b.st = st;
    if (threadIdx.x == 0) (void)xb_add(&bar[XB_XCNT(b.x)], 1u);
    return b;
}
__device__ __forceinline__ void xcd_barrier_complete(unsigned* bar, unsigned x, unsigned& nloc, unsigned& nx) {
    const unsigned G = gridDim.x * gridDim.y * gridDim.z;
    unsigned sum, cnt, mine, sp = 0u;
    for (;;) {
        sum = 0u; cnt = 0u; mine = 0u;
#pragma unroll
        for (unsigned j = 0; j < 16; ++j) { const unsigned c = xb_ld(&bar[XB_XCNT(j)]); sum += c; cnt += (c > 0u) ? 1u : 0u; mine = (j == x) ? c : mine; }
        if (sum == G) break;
        __builtin_amdgcn_s_sleep(1);
        if ((++sp & 255u) == 0u) { if (xb_ld(&bar[XB_TMO])) break; if (sp > XB_SPIN_CAP) { atomicAdd(&bar[XB_TMO], 1u); break; } }
    }
    nloc = mine > 0u ? mine : 1u; nx = cnt > 0u ? cnt : 1u;
}

__device__ __forceinline__ void xcd_barrier(const XcdBarrier& b) {
    asm volatile("s_waitcnt vmcnt(0)" ::: "memory");
    __syncthreads();
    if (threadIdx.x == 0) {
        unsigned* bar = b.bar;
        __builtin_amdgcn_s_waitcnt(0);
        unsigned nloc = b.st[0], nx = b.st[1];
        if (nloc == 0u) { xcd_barrier_complete(bar, b.x, nloc, nx); b.st[0] = nloc; b.st[1] = nx; }
        const unsigned old = xb_add(&bar[XB_XSUB(b.x)], 1u);
        const unsigned gen = old / nloc;
        if (old + 1u == (gen + 1u) * nloc) {
            __builtin_amdgcn_fence(__ATOMIC_RELEASE, "agent");
            asm volatile("s_waitcnt vmcnt(0)" ::: "memory");
            const unsigned og = xb_add(&bar[XB_TOP], 1u);
            const unsigned tg = og / nx;
            if (og + 1u == (tg + 1u) * nx) xb_add(&bar[XB_TOPGEN], 1u);
            else XB_SPIN(xb_ld(&bar[XB_TOPGEN]) == tg, bar);
            __builtin_amdgcn_fence(__ATOMIC_ACQUIRE, "agent");
            xb_add(&bar[XB_XGEN(b.x)], 1u);
            asm volatile("s_waitcnt vmcnt(0)" ::: "memory");
        } else {
            XB_SPIN(xb_ld(&bar[XB_XGEN(b.x)]) == gen, bar);
            __builtin_amdgcn_fence(__ATOMIC_ACQUIRE, "agent");
            asm volatile("s_waitcnt vmcnt(0)" ::: "memory");
        }
    }
    __syncthreads();
}


constexpr int NWAVES = 8, NTHREADS = NWAVES * 64;
constexpr int DM = 1024, NB = 8, SEQ = 8192, CTX = 256, BR = SEQ + CTX, MROWS = NB * BR, NIN = 1792, PQW = 1280, FF = 2816, NGU = 2 * FF;
constexpr size_t MiB = 1u << 20;
constexpr size_t WS_PART = 1 * MiB;
constexpr size_t WS_MOD = 8 * MiB;
constexpr size_t WS_TC = 9 * MiB;
constexpr size_t WS_ROPE = 10 * MiB;
constexpr size_t WS_W = 12 * MiB, W_LAYER = 22 * MiB, W_IN = 0, W_OUT = 3 * MiB + 512 * 1024, W_GU = W_OUT + 2 * MiB, W_DN = W_GU + 11 * MiB;
constexpr size_t WS_G = 56 * MiB;
constexpr size_t WS_P = WS_G, WS_O = WS_P + 165 * MiB, WS_UT = WS_O + 132 * MiB, WS_UTC = WS_UT + 64 * MiB;
constexpr size_t WS_H = WS_G + 363 * MiB;
constexpr size_t WS_X = WS_H + 132 * MiB;
constexpr size_t WS_UF = WS_X + 264 * MiB;
constexpr size_t WS_END = WS_UF + 64 * MiB;
static_assert(WS_W + 2 * W_LAYER <= WS_G && WS_UTC + 2 * MiB <= WS_H && W_DN + 5 * MiB + 512 * 1024 <= W_LAYER, "d_ws map");
constexpr int RING_BYTES = 131072, LDS_BYTES = 147456;

struct Args { const float* in[17]; float* out; unsigned char* ws; };

__device__ __forceinline__ float wave_sum(float v) {
    v = pg8::lane_xor_add<1>(v); v = pg8::lane_xor_add<2>(v); v = pg8::lane_xor_add<4>(v); v = pg8::lane_xor_add<8>(v); v = pg8::lane_xor_add<16>(v); v = pg8::lane_xor_add<32>(v);
    return v;
}
__device__ __forceinline__ unsigned pk2(float lo, float hi) { return pg8::cvt_pk_bf16(lo, hi); }

__device__ __forceinline__ void tr_item(const float* W, int K, int N, u16* WT, int k0, int n0, int drow0, LAS float* scr, int lane) {
#pragma unroll 8
    for (int i = 0; i < 32; ++i) { const int kk = 2 * i + (lane >> 5); scr[kk * 33 + (lane & 31)] = W[(size_t)(k0 + kk) * N + n0 + (lane & 31)]; }
    LDS_WAIT(); asm volatile("" ::: "memory");
    const int c = lane & 7;
#pragma unroll
    for (int j = 0; j < 4; ++j) { const int n = (lane >> 3) + 8 * j; const LAS float* s = scr + (8 * c) * 33 + n;
        v4u o; o.x = pk2(s[0 * 33], s[1 * 33]); o.y = pk2(s[2 * 33], s[3 * 33]); o.z = pk2(s[4 * 33], s[5 * 33]); o.w = pk2(s[6 * 33], s[7 * 33]);
        *(v4u*)(WT + (size_t)(drow0 + n) * K + k0 + 8 * c) = o; }
    LDS_WAIT(); asm volatile("" ::: "memory");
}
__device__ __forceinline__ void fmix_item(const float* Win, u16* WinT, int item, LAS float* scr, int lane) {
    const int g = item & 3, k0 = (item >> 2) * 32;
    LAS float* tabc = scr + 32 * 65; LAS float* tabs = tabc + 64;
    tabc[lane] = __builtin_amdgcn_cosf((float)lane * (1.0f / 64.0f)); tabs[lane] = __builtin_amdgcn_sinf((float)lane * (1.0f / 64.0f));
#pragma unroll 8
    for (int i = 0; i < 32; ++i) scr[i * 65 + lane] = Win[(size_t)(k0 + i) * 1536 + 640 + g * 64 + lane];
    LDS_WAIT(); asm volatile("" ::: "memory");
    float ac[32], as[32];
#pragma unroll
    for (int kk = 0; kk < 32; ++kk) { ac[kk] = 0.f; as[kk] = 0.f; }
#pragma unroll 2
    for (int c = 0; c < 64; ++c) { const int ti = (c * lane) & 63; const float tc = tabc[ti], ts = tabs[ti];
#pragma unroll
        for (int kk = 0; kk < 32; ++kk) { const float w = scr[kk * 65 + c]; ac[kk] += w * tc; as[kk] += w * ts; } }
    const int drow = 128 * (lane >> 5) + 32 * g + (lane & 31);
    u16* dc = WinT + (size_t)(1280 + drow) * 1024 + k0; u16* ds = WinT + (size_t)(1536 + drow) * 1024 + k0;
#pragma unroll
    for (int q = 0; q < 4; ++q) {
        v4u o; o.x = pk2(ac[8 * q], ac[8 * q + 1]); o.y = pk2(ac[8 * q + 2], ac[8 * q + 3]); o.z = pk2(ac[8 * q + 4], ac[8 * q + 5]); o.w = pk2(ac[8 * q + 6], ac[8 * q + 7]);
        *(v4u*)(dc + 8 * q) = o;
        v4u p; p.x = pk2(as[8 * q], as[8 * q + 1]); p.y = pk2(as[8 * q + 2], as[8 * q + 3]); p.z = pk2(as[8 * q + 4], as[8 * q + 5]); p.w = pk2(as[8 * q + 6], as[8 * q + 7]);
        *(v4u*)(ds + 8 * q) = p; }
    LDS_WAIT(); asm volatile("" ::: "memory");
}
__device__ __forceinline__ void ada_item(const float* c, const float* c_ctx, const float* w_ada, float* part, int item, LAS float* scr, int lane) {
    const int cb = item % 96, s = (item / 96) & 15, l = item / (96 * 16);
#pragma unroll
    for (int r = 0; r < 9; ++r) { const float v = (r < 8) ? c[r * 1024 + s * 64 + lane] : c_ctx[s * 64 + lane]; scr[r * 64 + lane] = v / (1.0f + __expf(-v)); }
    LDS_WAIT(); asm volatile("" ::: "memory");
    float acc[9];
#pragma unroll
    for (int r = 0; r < 9; ++r) acc[r] = 0.f;
    const float* wp = w_ada + (size_t)l * 1024 * 6144 + (size_t)(s * 64) * 6144 + cb * 64 + lane;
#pragma unroll 8
    for (int kk = 0; kk < 64; ++kk) { const float w = wp[(size_t)kk * 6144];
#pragma unroll
        for (int r = 0; r < 9; ++r) acc[r] += scr[r * 64 + kk] * w; }
#pragma unroll
    for (int r = 0; r < 9; ++r) part[((size_t)(s * 2 + l) * 9 + r) * 6144 + cb * 64 + lane] = acc[r];
    LDS_WAIT(); asm volatile("" ::: "memory");
}

__device__ __forceinline__ void norm_row_bf16(const float* xrow, const float* A, const float* B, u16* orow, int lane) {
    const f32x4* xr = (const f32x4*)xrow + lane; const f32x4* ar = (const f32x4*)A + lane; const f32x4* br = (const f32x4*)B + lane;
    f32x4 v[4]; float s = 0.f;
#pragma unroll
    for (int j = 0; j < 4; ++j) { v[j] = xr[64 * j]; s += (v[j].x * v[j].x + v[j].y * v[j].y) + (v[j].z * v[j].z + v[j].w * v[j].w); }
    const float rstd = 1.0f / sqrtf(wave_sum(s) * (1.0f / 1024.0f) + 1e-6f);
    unsigned long long* o8 = (unsigned long long*)orow + lane;
#pragma unroll
    for (int j = 0; j < 4; ++j) { const f32x4 y = v[j] * rstd * ar[64 * j] + br[64 * j];
        o8[64 * j] = (unsigned long long)pk2(y.x, y.y) | ((unsigned long long)pk2(y.z, y.w) << 32); }
}

__device__ __forceinline__ void conv_weights(const float* w_in_, const float* w_out_, const float* w_gate_, const float* w_up_, const float* w_down_, u16* wbase, int l, int gwx, int ngwx, LAS float* scr, int lane) {
    constexpr int I_IN = 16 * 40, I_OUT = 16 * 32, I_GT = 16 * 88, I_DN = 44 * 32, I_LAYER = I_IN + I_OUT + 2 * I_GT + I_DN;
    u16* wl = wbase + (size_t)l * (W_LAYER / 2);
    for (int it = gwx; it < I_LAYER; it += ngwx) { int r = it;
        if (r < I_IN) { const int kb = r / 40, nb0 = r % 40, nb = nb0 < 20 ? nb0 : nb0 + 8;
            const int n0 = nb * 32, slot = n0 < 640 ? n0 / 64 : (n0 - 896) / 64 + 10, bj = (n0 & 63) >> 5;
            tr_item(w_in_ + (size_t)l * 1024 * 1536, 1024, 1536, wl + W_IN / 2, kb * 64, n0, 256 * (slot >> 2) + 128 * bj + 32 * (slot & 3), scr, lane); continue; }
        r -= I_IN;
        if (r < I_OUT) { const int kb = r / 32, nb = r % 32; tr_item(w_out_ + (size_t)l * 1024 * 1024, 1024, 1024, wl + W_OUT / 2, kb * 64, nb * 32, nb * 32, scr, lane); continue; }
        r -= I_OUT;
        if (r < 2 * I_GT) { const int up = r / I_GT; r %= I_GT; const int kb = r / 88, nb = r % 88, n0 = nb * 32;
            tr_item((up ? w_up_ : w_gate_) + (size_t)l * 1024 * FF, 1024, FF, wl + W_GU / 2, kb * 64, n0, 256 * (n0 >> 7) + 128 * up + (n0 & 127), scr, lane); continue; }
        r -= 2 * I_GT;
        { const int kb = r / 32, nb = r % 32; tr_item(w_down_ + (size_t)l * FF * 1024, FF, 1024, wl + W_DN / 2, kb * 64, nb * 32, nb * 32, scr, lane); }
    }
    for (int it = gwx; it < 128; it += ngwx) fmix_item(w_in_ + (size_t)l * 1024 * 1536, wl + W_IN / 2, it, scr, lane);
}

__device__ constexpr float FFT_C32[16] = {1.000000000f, 0.980785280f, 0.923879533f, 0.831469612f, 0.707106781f, 0.555570233f, 0.382683432f, 0.195090322f, 0.000000000f, -0.195090322f, -0.382683432f, -0.555570233f, -0.707106781f, -0.831469612f, -0.923879533f, -0.980785280f};
__device__ constexpr float FFT_S32[16] = {0.000000000f, 0.195090322f, 0.382683432f, 0.555570233f, 0.707106781f, 0.831469612f, 0.923879533f, 0.980785280f, 1.000000000f, 0.980785280f, 0.923879533f, 0.831469612f, 0.707106781f, 0.555570233f, 0.382683432f, 0.195090322f};
template <int HALF> __device__ __forceinline__ void fft32_stage(float (&xr)[32], float (&xi)[32]) {
#pragma unroll
    for (int blk = 0; blk < 32; blk += 2 * HALF)
#pragma unroll
        for (int j = 0; j < HALF; ++j) { const int i0 = blk + j, i1 = i0 + HALF, m = j * (16 / HALF);
            const float tr = xr[i0] - xr[i1], ti = xi[i0] - xi[i1]; xr[i0] += xr[i1]; xi[i0] += xi[i1];
            if (m == 0) { xr[i1] = tr; xi[i1] = ti; }
            else if (m == 8) { xr[i1] = ti; xi[i1] = -tr; }
            else { const float c = FFT_C32[m], s = FFT_S32[m]; xr[i1] = tr * c + ti * s; xi[i1] = ti * c - tr * s; } }
}
__device__ __forceinline__ constexpr int bitrev5(int k) { return ((k & 1) << 4) | ((k & 2) << 2) | (k & 4) | ((k & 8) >> 2) | ((k & 16) >> 4); }
__device__ __forceinline__ void fft32_item(const u16* utrow, u16* Zb, int b, int n, int l2) {
    unsigned wre[32], wim[32], ox[32], oy[32];
#pragma unroll
    for (int j = 0; j < 32; ++j) { wre[j] = *(const unsigned*)(utrow + 256 * j + l2); wim[j] = *(const unsigned*)(utrow + 8192 + 256 * j + l2); }
#pragma unroll
    for (int h = 0; h < 2; ++h) {
        float xr[32], xi[32];
#pragma unroll
        for (int j = 0; j < 32; ++j) { xr[j] = __uint_as_float(h ? (wre[j] & 0xffff0000u) : (wre[j] << 16)); xi[j] = -__uint_as_float(h ? (wim[j] & 0xffff0000u) : (wim[j] << 16)); }
        fft32_stage<16>(xr, xi); fft32_stage<8>(xr, xi); fft32_stage<4>(xr, xi); fft32_stage<2>(xr, xi); fft32_stage<1>(xr, xi);
#pragma unroll
        for (int k1 = 0; k1 < 32; ++k1) { const float yx = xr[bitrev5(k1)], yy = xi[bitrev5(k1)];
            const float rev = (float)((k1 * (l2 + h)) & 8191) * (1.0f / 8192.0f); const float ca = __builtin_amdgcn_cosf(rev), sa = __builtin_amdgcn_sinf(rev);
            const float zx = yx * ca + yy * sa, zy = yy * ca - yx * sa;
            if (h == 0) { ox[k1] = pk2(zx, 0.f); oy[k1] = pk2(-zy, 0.f); } else { ox[k1] |= pk2(0.f, zx); oy[k1] |= pk2(0.f, -zy); } }
    }
#pragma unroll
    for (int k1 = 0; k1 < 32; ++k1) { u16* zp = Zb + ((size_t)((b * 32 + k1) * 256 + n)) * 512 + l2; *(unsigned*)zp = ox[k1]; *(unsigned*)(zp + 256) = oy[k1]; }
}

template <bool FINAL, bool SRC16> __device__ __forceinline__ void norm4_rows(const void* x0v, const float* A, const float* B, void* o0, int lane) {
    f32x4 v[4][4]; float s[4];
#pragma unroll
    for (int r = 0; r < 4; ++r)
#pragma unroll
        for (int j = 0; j < 4; ++j) {
            if (SRC16) { typedef unsigned u32x2 __attribute__((ext_vector_type(2))); const u32x2 w = ((const u32x2*)((const u16*)x0v + (size_t)r * 1024))[lane + 64 * j];
                v[r][j] = (f32x4){__uint_as_float(w.x << 16), __uint_as_float(w.x & 0xffff0000u), __uint_as_float(w.y << 16), __uint_as_float(w.y & 0xffff0000u)}; }
            else v[r][j] = ((const f32x4*)((const float*)x0v + (size_t)r * 1024))[lane + 64 * j]; }
#pragma unroll
    for (int r = 0; r < 4; ++r) { s[r] = 0.f;
#pragma unroll
        for (int j = 0; j < 4; ++j) s[r] += (v[r][j].x * v[r][j].x + v[r][j].y * v[r][j].y) + (v[r][j].z * v[r][j].z + v[r][j].w * v[r][j].w); }
#pragma unroll
    for (int r = 0; r < 4; ++r) { s[r] = pg8::lane_xor_add<1>(s[r]); s[r] = pg8::lane_xor_add<2>(s[r]); s[r] = pg8::lane_xor_add<4>(s[r]); s[r] = pg8::lane_xor_add<8>(s[r]); s[r] = pg8::lane_xor_add<16>(s[r]); s[r] = pg8::lane_xor_add<32>(s[r]); }
    f32x4 a[4], b[4];
#pragma unroll
    for (int j = 0; j < 4; ++j) { a[j] = ((const f32x4*)A)[lane + 64 * j]; b[j] = FINAL ? (f32x4){0.f, 0.f, 0.f, 0.f} : ((const f32x4*)B)[lane + 64 * j]; }
#pragma unroll
    for (int r = 0; r < 4; ++r) { const float rstd = 1.0f / sqrtf(s[r] * (1.0f / 1024.0f) + 1e-6f);
#pragma unroll
        for (int j = 0; j < 4; ++j) { const f32x4 y = v[r][j] * rstd * a[j] + b[j];
            if (FINAL) ((f32x4*)((float*)o0 + (size_t)r * 1024))[lane + 64 * j] = y;
            else ((unsigned long long*)((u16*)o0 + (size_t)r * 1024))[lane + 64 * j] = (unsigned long long)pk2(y.x, y.y) | ((unsigned long long)pk2(y.z, y.w) << 32); } }
}

__global__ void __launch_bounds__(NTHREADS, 2) hybrid_fwd(Args args) {
    extern __shared__ __attribute__((aligned(16))) unsigned char lds[];
    cg::grid_group grid = cg::this_grid();
    LAS unsigned char* ldsA = (LAS unsigned char*)lds;
#define PH_BASE() size_t wz_ = 0; asm volatile("" : "+s"(wz_)); unsigned char* ws = args.ws + wz_; int G = gridDim.x; asm volatile("" : "+s"(G)); int bx = blockIdx.x; asm volatile("" : "+s"(bx)); \
    const int vcu = (G % 8 == 0) ? (bx % 8) * (G / 8) + bx / 8 : bx; const int NGW = G * NWAVES, NGT = NGW * 64; (void)vcu; (void)NGT; (void)NGW
#define PH_IDS() int tid_o = threadIdx.x; asm volatile("" : "+v"(tid_o)); const int lane = tid_o & 63, wave = __builtin_amdgcn_readfirstlane(tid_o >> 6), gw = vcu * NWAVES + wave, gtid = gw * 64 + lane; (void)gtid; (void)gw
#define x_in (args.in[0])
#define c_in (args.in[1])
#define ctx_in (args.in[2])
#define cctx_in (args.in[3])
#define w_ada (args.in[4])
#define b_ada (args.in[5])
#define g_mix (args.in[6])
#define g_ffn (args.in[7])
#define w_in (args.in[8])
#define q_norm (args.in[9])
#define k_norm (args.in[10])
#define sink (args.in[11])
#define w_out (args.in[12])
#define w_gate (args.in[13])
#define w_up (args.in[14])
#define w_down (args.in[15])
#define g_final (args.in[16])
#define PART ((float*)(ws + WS_PART))
#define MOD ((float*)(ws + WS_MOD))
#define TC ((u16*)(ws + WS_TC))
#define ROPE ((float*)(ws + WS_ROPE))
#define Pb ((u16*)(ws + WS_P))
#define Ob ((u16*)(ws + WS_O))
#define UT ((u16*)(ws + WS_UT))
#define UTC ((u16*)(ws + WS_UTC))
#define Gb ((u16*)(ws + WS_G))
#define Hb ((u16*)(ws + WS_H))
#define X ((u16*)(ws + WS_X))
#define UF ((u16*)(ws + WS_UF))
#define FLAGS ((unsigned*)ws)
#define WL ((const u16*)(ws + WS_W + (size_t)l * W_LAYER))
#define MODL (MOD + (size_t)l * 9 * 6 * 1024)
#define GRID_BAR() do { XcdBarrier b_; b_.bar = (unsigned*)args.ws + 1024; b_.x = xb_xcc_id(); b_.st = (volatile LAS unsigned*)(ldsA + RING_BYTES + 64); xcd_barrier(b_); } while (0)

    {
        PH_BASE(); PH_IDS();
        LAS float* scr = (LAS float*)(ldsA + wave * 16384);
        if (bx == 0) { if (tid_o < 2) __hip_atomic_store(FLAGS + 64 * tid_o, 0u, __ATOMIC_RELAXED, __HIP_MEMORY_SCOPE_AGENT);
            for (int w = tid_o; w < XCD_BAR_WORDS; w += NTHREADS) __hip_atomic_store(FLAGS + 1024 + w, 0u, __ATOMIC_RELAXED, __HIP_MEMORY_SCOPE_AGENT); }
        if (tid_o < 2) ((volatile LAS unsigned*)(ldsA + RING_BYTES + 64))[tid_o] = 0u;
        for (int it = gw; it < 2 * 16 * 96; it += NGW) ada_item(c_in, cctx_in, w_ada, PART, it, scr, lane);
        for (int idx = gtid; idx < 256 * 64; idx += NGT) { const int k = idx >> 6, kk0 = (idx & 63) << 3; const bool sn = kk0 >= 256; const int l0 = kk0 & 255;
            float v[8];
#pragma unroll
            for (int j = 0; j < 8; ++j) { const float rev = (float)((k * (l0 + j)) & 255) * (1.0f / 256.0f); v[j] = sn ? -__builtin_amdgcn_sinf(rev) : __builtin_amdgcn_cosf(rev); }
            v4u o; o.x = pk2(v[0], v[1]); o.y = pk2(v[2], v[3]); o.z = pk2(v[4], v[5]); o.w = pk2(v[6], v[7]);
            *(v4u*)(TC + (size_t)idx * 8) = o; }
    }
    grid.sync();
    (void)xcd_barrier_post((unsigned*)args.ws + 1024, (volatile LAS unsigned*)(ldsA + RING_BYTES + 64));
    { PH_BASE(); PH_IDS();
    for (int idx = gtid; idx < 2 * 9 * 1024; idx += NGT) { const int col = idx & 1023, r = (idx >> 10) % 9, l = idx / 9216;
        float m[6];
#pragma unroll
        for (int w = 0; w < 6; ++w) { float a = b_ada[l * 6144 + w * 1024 + col];
            for (int s = 0; s < 16; ++s) a += PART[((size_t)(s * 2 + l) * 9 + r) * 6144 + w * 1024 + col];
            m[w] = a; }
        float* o = MOD + (size_t)((l * 9 + r) * 6) * 1024 + col;
        o[0] = g_mix[l * 1024 + col] * (1.0f + m[1]); o[1024] = m[0]; o[2048] = m[2];
        o[3072] = g_ffn[l * 1024 + col] * (1.0f + m[4]); o[4096] = m[3]; o[5120] = m[5]; }
    }
    GRID_BAR();

#pragma nounroll
    for (int l = 0; l < 2; ++l) {
        { PH_BASE(); PH_IDS();
        if (l == 0) {
            LAS float* scr = (LAS float*)(ldsA + wave * 16384);
            conv_weights(w_in, w_out, w_gate, w_up, w_down, (u16*)(ws + WS_W), 0, gw, NGW, scr, lane);
            for (int row = 4 * gw; row < MROWS; row += 4 * NGW) { const int b = row / BR, p = row % BR; const bool is_ctx = p < CTX; const int r = is_ctx ? 8 : b;
                norm4_rows<false, false>(is_ctx ? ctx_in + (size_t)(b * CTX + p) * DM : x_in + (size_t)(b * SEQ + p - CTX) * DM, MODL + (size_t)(r * 6 + 0) * 1024, MODL + (size_t)(r * 6 + 1) * 1024, Hb + (size_t)row * DM, lane); }
        } else {
            for (int q = gw; q < NB * CTX / 4; q += NGW) { const int row = (q >> 6) * BR + (q & 63) * 4;
                norm4_rows<false, true>(X + (size_t)row * DM, MODL + (size_t)(8 * 6 + 0) * 1024, MODL + (size_t)(8 * 6 + 1) * 1024, Hb + (size_t)row * DM, lane); }
        } }
        GRID_BAR();
#pragma nounroll
        for (int sp = 0; sp < 2; ++sp) {
            PH_BASE();
            if (sp == 1 && bx >= 56) { PH_IDS(); const int gw2 = (bx - 56) * NWAVES + wave, NGW2 = (G - 56) * NWAVES;
                for (int it = gw2; it < 2048 * 2; it += NGW2) { const int bn = it >> 1, l2 = ((it & 1) << 7) + 2 * lane;
                    fft32_item(UT + (size_t)bn * 16384, UF, bn >> 8, bn & 255, l2); } }
            else { pg8::Gemm g{Hb, WL + W_IN / 2, MROWS, NIN, DM}; pg8::RowOrder S; S.init(NIN, G, bx, sp == 0 ? 1 : 2);
                pg8::EpiInProj E{Pb, UT, UTC, q_norm + l * 64, k_norm + l * 64};
                pg8::gemm_phase<pg8::EpiInProj, pg8::RowOrder, true, true>(ldsA, g, S, E); }
            GRID_BAR();
        }
        {
            PH_BASE();
            const int pair = vcu >> 4, jj = vcu & 15, b = pair >> 1, kvh = pair & 1;
            const attn_body::bf16* Pa = (const attn_body::bf16*)Pb; attn_body::bf16* Oa = (attn_body::bf16*)Ob;
            const int cid = ((vcu & 31) != 0) ? (vcu & 31) - 1 + 31 * (vcu >> 5) : 1000;
            const int nA = 6 + ((l == 0 && cid < 96) ? 1 : 0);
            float mfix; { float gq = 0.f, gk = 0.f;
#pragma unroll 8
                for (int j = 0; j < 64; ++j) { gq = __builtin_fmaxf(gq, __builtin_fabsf(q_norm[l * 64 + j])); gk = __builtin_fmaxf(gk, __builtin_fabsf(k_norm[l * 64 + j])); }
                mfix = __uint_as_float(__builtin_amdgcn_readfirstlane(__float_as_uint(64.0f * 1.02f * 0.125f * 1.4426950408889634f * gq * gk))); }
            const bool fixm = mfix <= 48.0f;
#pragma nounroll
            for (int i = 0; i < nA; ++i) {
                const attn_body::bf16 *Qu, *Kh, *Vh; attn_body::bf16* Ou; int NT; float sk = -INFINITY;
                if (i < 6) { const int idx = i * 16 + jj, hq = kvh * 3 + (idx >> 5), qb = idx & 31; const size_t r0 = (size_t)b * BR;
                    Qu = Pa + (r0 + CTX + qb * 256) * PQW + hq * 64; Kh = Pa + r0 * PQW + (6 + kvh) * 64; Vh = Pa + r0 * PQW + (8 + kvh) * 64; Ou = Oa + (r0 + CTX + qb * 256) * 1024 + hq * 64; NT = 132; }
                else { const int ty = cid / 48, rem = cid % 48, cb = rem / 6, hq = rem % 6, ckv = hq / 3; const size_t r0 = (size_t)cb * BR;
                    const int qc = ty ? 10 + hq : hq, kc = ty ? 16 + ckv : 6 + ckv, vc = ty ? 18 + ckv : 8 + ckv, oc = ty ? 640 + hq * 64 : hq * 64;
                    Qu = Pa + r0 * PQW + qc * 64; Kh = Pa + r0 * PQW + kc * 64; Vh = Pa + r0 * PQW + vc * 64; Ou = Oa + r0 * 1024 + oc; NT = 4;
                    if (ty) sk = sink[l * 6 + hq] * 1.4426950408889634f; }
#ifndef NO_ATTN_A
                if (i < 6 && fixm) attn_body::attn_unit<8, false, true>(Qu, Kh, Vh, Ou, NT, 0, 0, sk, mfix, (char*)lds);
                else attn_body::attn_unit<8, false, false>(Qu, Kh, Vh, Ou, NT, 0, 0, sk, 0.f, (char*)lds);
#endif
            }
#pragma nounroll
            for (int i = 0; i < 6; ++i) {
                const int idx = i * 16 + jj, hq = kvh * 3 + (idx >> 5), qb = idx & 31, q0 = qb * 256; const size_t r0 = (size_t)b * BR;
                const int kb0 = q0 >= 128 ? q0 - 128 : 0, ke = q0 + 384 <= SEQ ? q0 + 384 : SEQ, NT = 4 + (ke - kb0) / 64;
#ifndef NO_ATTN_W
                attn_body::attn_unit<8, true, false>(Pa + (r0 + CTX + q0) * PQW + (10 + hq) * 64, Pa + r0 * PQW + (16 + kvh) * 64, Pa + r0 * PQW + (18 + kvh) * 64,
                                              Oa + (r0 + CTX + q0) * 1024 + 640 + hq * 64, NT, kb0, q0 - kb0, sink[l * 6 + hq] * 1.4426950408889634f, 0.f, (char*)lds);
#endif
            }
            __syncthreads();
            const int nF = (l == 0) ? 2 : 1;
#pragma nounroll
            for (int v = 0; v < nF; ++v) {
                pg8::Gemm g = v == 0 ? pg8::Gemm{TC, UF, 256, 65536, 512} : pg8::Gemm{TC, UTC, 256, 2048, 512};
                pg8::StaticOrder S; S.init(g.M, g.N, G, bx);
                pg8::EpiFourier E{Ob, v == 0 ? 1 : 0, v == 0 ? 0.001381067932004976f : 0.0078125f};
                pg8::gemm_phase<pg8::EpiFourier, pg8::StaticOrder, true, true>(ldsA, g, S, E);
                __syncthreads();
            }
        }
        GRID_BAR();
        { PH_BASE(); pg8::Gemm g{Ob, WL + W_OUT / 2, MROWS, DM, DM}; pg8::RowOrder S; S.init(DM, G, bx, l == 1);
          pg8::EpiResid E{l == 0 ? x_in : nullptr, l == 0 ? ctx_in : nullptr, X, MODL + 2 * 1024};
          pg8::gemm_phase<pg8::EpiResid, pg8::RowOrder, true, true>(ldsA, g, S, E); }
        GRID_BAR();
        { PH_BASE(); PH_IDS();
        for (int row = 4 * gw; row < MROWS; row += 4 * NGW) { const int b = row / BR, p = row % BR; const bool is_ctx = p < CTX; const int r = is_ctx ? 8 : b;
            if (l == 1 && is_ctx) continue;
            norm4_rows<false, true>(X + (size_t)row * DM, MODL + (size_t)(r * 6 + 3) * 1024, MODL + (size_t)(r * 6 + 4) * 1024, Hb + (size_t)row * DM, lane); } }
        GRID_BAR();
        { PH_BASE(); pg8::Gemm g{Hb, WL + W_GU / 2, MROWS, NGU, DM}; pg8::RowOrder S; S.init(NGU, G, bx, l == 1);
          pg8::EpiSwiglu E{Gb};
          pg8::gemm_phase<pg8::EpiSwiglu, pg8::RowOrder, true, true>(ldsA, g, S, E); }
        GRID_BAR();
        { const int nsp = (l == 0) ? 2 : 1;
#pragma nounroll
          for (int sp = 0; sp < nsp; ++sp) {
            PH_BASE();
            if (sp == 1 && bx >= 32) { PH_IDS(); const int gw2 = (bx - 32) * NWAVES + wave, NGW2 = (G - 32) * NWAVES;
                for (int q = gw2; q < NB * SEQ / 4; q += NGW2) { const int b = q >> 11, row = b * BR + CTX + ((q & 2047) << 2);
                    norm4_rows<false, true>(X + (size_t)row * DM, MOD + (size_t)((9 + b) * 6 + 0) * 1024, MOD + (size_t)((9 + b) * 6 + 1) * 1024, Hb + (size_t)row * DM, lane); }
                conv_weights(w_in, w_out, w_gate, w_up, w_down, (u16*)(ws + WS_W), 1, gw2, NGW2, (LAS float*)(ldsA + wave * 16384), lane); }
            else { pg8::Gemm g{Gb, WL + W_DN / 2, MROWS, DM, FF}; pg8::RowOrder S; S.init(DM, G, bx, sp == 0 ? 1 : 2);
                pg8::EpiResid E{nullptr, nullptr, X, MODL + 5 * 1024};
                pg8::gemm_phase<pg8::EpiResid, pg8::RowOrder, true, true>(ldsA, g, S, E); }
            GRID_BAR();
          } }
    }
    { PH_BASE(); PH_IDS();
    for (int row = 4 * gw; row < NB * SEQ; row += 4 * NGW) { const int b = row >> 13, t = row & 8191;
        norm4_rows<true, true>(X + (size_t)(b * BR + CTX + t) * DM, g_final, nullptr, args.out + (size_t)row * DM, lane); } }
}

extern "C" void kernel_launch(void* const* d_in, const int* in_sizes, int n_in, void* d_out, int out_size, void* d_ws, size_t ws_size, hipStream_t stream) {
    static int grid = 0;
    if (grid == 0) {
        if (n_in != 17 || in_sizes[0] != NB * SEQ * DM || out_size != NB * SEQ * DM || ws_size < WS_END) {
            fprintf(stderr, "kernel_launch: unexpected shapes (n_in %d, in0 %d, out %d, ws %zu, need %zu); nothing launched\n", n_in, n_in > 0 ? in_sizes[0] : -1, out_size, ws_size, (size_t)WS_END); grid = -1; return; }
        int dev = 0, cus = 0, per_cu = 0;
        if (hipGetDevice(&dev) != hipSuccess || hipDeviceGetAttribute(&cus, hipDeviceAttributeMultiprocessorCount, dev) != hipSuccess) { fprintf(stderr, "kernel_launch: device query failed\n"); grid = -1; return; }
        if (hipFuncSetAttribute((const void*)hybrid_fwd, hipFuncAttributeMaxDynamicSharedMemorySize, LDS_BYTES) != hipSuccess) { fprintf(stderr, "kernel_launch: hipFuncSetAttribute failed\n"); grid = -1; return; }
        if (hipOccupancyMaxActiveBlocksPerMultiprocessor(&per_cu, (const void*)hybrid_fwd, NTHREADS, LDS_BYTES) != hipSuccess || per_cu < 1) { fprintf(stderr, "kernel_launch: occupancy query says %d blocks per CU\n", per_cu); per_cu = 1; }
        (void)hipGetLastError();
        grid = cus;
        if (grid != 256) fprintf(stderr, "kernel_launch: %d CUs; the mixer phase's static schedule assumes 256\n", grid);
    }
    if (grid < 0) return;
    Args a{};
    for (int i = 0; i < 17; ++i) a.in[i] = (const float*)d_in[i];
    a.out = (float*)d_out; a.ws = (unsigned char*)d_ws;
    void* kargs[] = {&a};
    const hipError_t e = hipLaunchCooperativeKernel((const void*)hybrid_fwd, dim3(grid), dim3(NTHREADS), kargs, LDS_BYTES, stream);
    if (e != hipSuccess) fprintf(stderr, "kernel_launch: cooperative launch failed: %s (grid %d)\n", hipGetErrorString(e), grid);
}
```

```cpp
#include <hip/hip_runtime.h>
#include <hip/hip_cooperative_groups.h>
#include <cstdio>
#include <cstdint>
#include <hip/hip_bf16.h>
#include <cmath>
namespace pg8 {
#define PG8_LAS __attribute__((address_space(3)))
typedef unsigned short bf16_t;
typedef short bf16x8 __attribute__((ext_vector_type(8)));
typedef float f32x4 __attribute__((ext_vector_type(4)));
typedef unsigned u32x4 __attribute__((ext_vector_type(4)));
constexpr int BM = 256, BK = 64, HALF = 128, HTB = HALF * BK * 2  , STAGE_BYTES = 8 * HTB, NXCD = 8, WGM = 8;

__host__ __device__ __forceinline__ int lds_byte(int r, int c) { const int st = (r >> 4) * 2 + (c >> 5), rr = r & 15, cc = c & 31, ob = rr * 64 + cc * 2; return st * 1024 + (ob ^ (((ob >> 9) & 1) << 5)); }
__host__ __device__ __forceinline__ void stage_rc(int b, int& R, int& C) { const int st = b / 1024, sb = b % 1024, swz = sb ^ (((sb >> 9) & 1) << 5); R = (st >> 1) * 16 + swz / 64; C = (st & 1) * 32 + (swz % 64) / 2; }
__host__ __device__ __forceinline__ int perm32(int rho) { const int n = rho >> 4, i = rho & 15; return 8 * (i >> 2) + 4 * n + (i & 3); }

struct Unit { int pm, pn; };
struct Gemm { const bf16_t* A; const bf16_t* Bt; int M, N, K; };

struct StaticOrder {
    int nM, nN, nwg, G, c;
    __host__ __device__ void init(int M, int N, int G_, int c_) { nM = M / BM; nN = N / BM; nwg = nM * nN; G = G_; c = c_; }
    __host__ __device__ bool next(int i, Unit& u) const {
        const long L = (long)i * G + c; if (L >= nwg) return false;
        int wgid = (int)L; { const int q = nwg / NXCD, r = nwg % NXCD, xcd = wgid % NXCD, off = wgid / NXCD; wgid = (xcd < r ? xcd * (q + 1) : r * (q + 1) + (xcd - r) * q) + off; }
        const int nig = WGM * nN, gid = wgid / nig, fm = gid * WGM, gsz = (nM - fm) < WGM ? (nM - fm) : WGM;
        u.pm = fm + ((wgid % nig) % gsz); u.pn = (wgid % nig) / gsz; return true;
    }
    __device__ __forceinline__ void a_ready(const Unit&) const {}
    __device__ __forceinline__ void done(const Unit&) const {}
};

__device__ __forceinline__ unsigned cvt_pk_bf16(float lo, float hi) { unsigned r; asm volatile("v_cvt_pk_bf16_f32 %0, %1, %2" : "=v"(r) : "v"(lo), "v"(hi)); return r; }
typedef float f32x2 __attribute__((ext_vector_type(2)));
template <int XM> __device__ __forceinline__ float lane_xor_add(float v) {
    if constexpr (XM == 32) { const auto rr = __builtin_amdgcn_permlane32_swap(__float_as_uint(v), __float_as_uint(v), false, false); return __uint_as_float(rr[0]) + __uint_as_float(rr[1]); }
    else return v + __uint_as_float((unsigned)__builtin_amdgcn_ds_swizzle((int)__float_as_uint(v), (XM << 10) | 0x1f));
}
typedef unsigned u32x4 __attribute__((ext_vector_type(4)));
constexpr float QK_C2 = 0.125f * 1.4426950408889634f;
constexpr int BR_TILES = 33;

struct RowOrder {
    StaticOrder s; int mode, nn;
    __host__ __device__ void init(int N, int G_, int c_, int mode_) { mode = mode_; nn = N / BM; s.init(mode_ >= 3 ? 32768 : mode_ == 1 ? 65536 : 67584, N, G_, c_); }
    __host__ __device__ bool next(int i, Unit& u) const {
        if (mode == 2) { if (i != 0 || s.c >= 8 * nn) return false; u.pm = (s.c / nn) * 33; u.pn = s.c % nn; return true; }
        if (!s.next(i, u)) return false; if (mode == 1) u.pm = u.pm + (u.pm >> 5) + 1; else if (mode >= 3) u.pm = u.pm + (u.pm >> 5) + 1 + 132 * (mode - 3); return true; }
    __device__ __forceinline__ void a_ready(const Unit&) const {}
    __device__ __forceinline__ void done(const Unit&) const {}
};

struct EpiInProj {
    static constexpr bool PERM = true, AFTER_DRAIN = false;
    bf16_t* P; bf16_t* UT; bf16_t* UTc; const float* qn; const float* kn;
    __device__ __forceinline__ void operator()(const f32x4 (&acc)[2][2][4][2], const Unit& u, int wr, int wc, int fr, int fq) const {
        const int b = u.pm / BR_TILES, pt = u.pm % BR_TILES; const bool is_ctx = (pt == 0);
        const int slot = u.pn * 4 + wc;
        const int rloc = wr * 64 + fr;
        if (slot >= 20) {
            const int which = (slot - 20) >> 2, g = (slot - 20) & 3, qi = fr & 3; const bool r1 = (fr & 1) != 0, h1 = (fr & 2) != 0;
            const unsigned selB = r1 ? 0x03020706u : 0x05040100u;
            bf16_t* base; size_t pitch;
            if (is_ctx) { base = UTc + (size_t)(b * 256 + g * 64) * 512 + which * 256 + (rloc - qi); pitch = 512; }
            else { base = UT + (size_t)(b * 256 + g * 64) * 16384 + which * 8192 + (pt - 1) * 256 + (rloc - qi); pitch = 16384; }
            typedef unsigned u32x2 __attribute__((ext_vector_type(2)));
#pragma unroll
            for (int ai = 0; ai < 2; ++ai)
#pragma unroll
                for (int m = 0; m < 4; ++m)
#pragma unroll
                    for (int bj = 0; bj < 2; ++bj)
#pragma unroll
                        for (int n = 0; n < 2; ++n) { const f32x4 v = acc[ai][bj][m][n]; const unsigned w0 = cvt_pk_bf16(v[0], v[1]), w1 = cvt_pk_bf16(v[2], v[3]);
                            const unsigned snd = h1 ? w0 : w1, rcv = (unsigned)__builtin_amdgcn_update_dpp(0, (int)snd, 0x4E, 0xF, 0xF, true);
                            const unsigned a0 = h1 ? rcv : w0, a1 = h1 ? w1 : rcv;
                            const unsigned p0 = (unsigned)__builtin_amdgcn_update_dpp(0, (int)a0, 0xB1, 0xF, 0xF, true), p1 = (unsigned)__builtin_amdgcn_update_dpp(0, (int)a1, 0xB1, 0xF, 0xF, true);
                            u32x2 x; x.x = __builtin_amdgcn_perm(p0, a0, selB); x.y = __builtin_amdgcn_perm(p1, a1, selB);
                            *(u32x2*)(base + (size_t)(32 * bj + 8 * fq + 4 * n + qi) * pitch + ai * 128 + m * 16) = x; }
            return;
        }
        const bool isq = slot < 6 || (slot >= 10 && slot < 16);
        const bool isk = slot == 6 || slot == 7 || slot == 16 || slot == 17;
        const bool donorm = slot < 8;
        const bool dorope = (isq || isk) && !is_ctx;
        const float* gam = slot < 6 ? qn : kn;
        f32x4 gv[2][2];
#pragma unroll
        for (int bj = 0; bj < 2; ++bj)
#pragma unroll
            for (int n = 0; n < 2; ++n) gv[bj][n] = donorm ? *(const f32x4*)(gam + 32 * bj + 8 * fq + 4 * n) : (f32x4){1.f, 1.f, 1.f, 1.f};
        const float qs = isq ? QK_C2 : 1.f;
        bf16_t* orow0 = P + (size_t)(u.pm * 256 + rloc) * 1280 + slot * 64 + 8 * fq;
        float rf[2][4];
#pragma unroll
        for (int n = 0; n < 2; ++n)
#pragma unroll
            for (int j = 0; j < 4; ++j) rf[n][j] = __builtin_amdgcn_exp2f(-(float)((8 * fq + 4 * n + j) & 15) * (13.287712379549449f / 16.0f)) * 0.15915494309189535f;
        const int tl0 = (pt - 1) * 256 + rloc;
#pragma unroll
        for (int ai = 0; ai < 2; ++ai)
#pragma unroll
            for (int m = 0; m < 4; ++m) {
                f32x4 v[2][2];
#pragma unroll
                for (int bj = 0; bj < 2; ++bj)
#pragma unroll
                    for (int n = 0; n < 2; ++n) v[bj][n] = acc[ai][bj][m][n];
                if (donorm) {
                    float ss = 0.f;
#pragma unroll
                    for (int bj = 0; bj < 2; ++bj)
#pragma unroll
                        for (int n = 0; n < 2; ++n) ss += (v[bj][n][0] * v[bj][n][0] + v[bj][n][1] * v[bj][n][1]) + (v[bj][n][2] * v[bj][n][2] + v[bj][n][3] * v[bj][n][3]);
                    ss = lane_xor_add<16>(ss); ss = lane_xor_add<32>(ss);
                    const float rs = 1.0f / sqrtf(ss * (1.0f / 64.0f) + 1e-6f);
#pragma unroll
                    for (int bj = 0; bj < 2; ++bj)
#pragma unroll
                        for (int n = 0; n < 2; ++n) v[bj][n] = v[bj][n] * rs * gv[bj][n];
                }
                if (dorope) {
                    const int tl = tl0 + ai * 128 + m * 16; const float fp = (float)(fq >= 2 ? (tl & 63) : (tl >> 6));
#pragma unroll
                    for (int n = 0; n < 2; ++n) {
                        f32x4 cc, sn;
#pragma unroll
                        for (int j = 0; j < 4; ++j) { const float rev = __builtin_amdgcn_fractf(fp * rf[n][j]); cc[j] = __builtin_amdgcn_cosf(rev); sn[j] = __builtin_amdgcn_sinf(rev); }
                        const f32x4 x1 = v[0][n], x2 = v[1][n];
                        v[0][n] = x1 * cc - x2 * sn; v[1][n] = x2 * cc + x1 * sn;
                    }
                }
#pragma unroll
                for (int bj = 0; bj < 2; ++bj) {
                    const f32x4 v0 = v[bj][0] * qs, v1 = v[bj][1] * qs;
                    u32x4 w; w.x = cvt_pk_bf16(v0[0], v0[1]); w.y = cvt_pk_bf16(v0[2], v0[3]); w.z = cvt_pk_bf16(v1[0], v1[1]); w.w = cvt_pk_bf16(v1[2], v1[3]);
                    *(u32x4*)(orow0 + (size_t)(ai * 128 + m * 16) * 1280 + 32 * bj) = w;
                }
            }
    }
};

struct EpiFourier {
    static constexpr bool PERM = true, AFTER_DRAIN = false;
    bf16_t* O; int mode; float scale;
    __device__ __forceinline__ void operator()(const f32x4 (&acc)[2][2][4][2], const Unit& u, int wr, int wc, int fr, int fq) const {
        const size_t row0 = mode ? (size_t)(u.pn >> 5) * 8448 + 256 + (u.pn & 31) : (size_t)u.pn * 8448; const int rstride = mode ? 32 : 1;
        bf16_t* base = O + row0 * 1024 + 384 + wc * 32 + 8 * fq;
#pragma unroll
        for (int ai = 0; ai < 2; ++ai)
#pragma unroll
            for (int m = 0; m < 4; ++m) { bf16_t* rowp = base + (size_t)((ai * 128 + wr * 64 + m * 16 + fr) * rstride) * 1024;
#pragma unroll
                for (int bj = 0; bj < 2; ++bj) { const f32x4 v0 = acc[ai][bj][m][0] * scale, v1 = acc[ai][bj][m][1] * scale;
                    u32x4 w; w.x = cvt_pk_bf16(v0[0], v0[1]); w.y = cvt_pk_bf16(v0[2], v0[3]); w.z = cvt_pk_bf16(v1[0], v1[1]); w.w = cvt_pk_bf16(v1[2], v1[3]);
                    *(u32x4*)(rowp + bj * 128) = w; } }
    }
};

struct EpiResid {
    static constexpr bool PERM = true, AFTER_DRAIN = false;
    const float* xin; const float* cin;
    bf16_t* X; const float* gate;
    __device__ __forceinline__ void operator()(const f32x4 (&acc)[2][2][4][2], const Unit& u, int wr, int wc, int fr, int fq) const {
        const int b = u.pm / BR_TILES, pt = u.pm % BR_TILES; const bool is_ctx = (pt == 0);
        const float* gp = gate + (size_t)(is_ctx ? 8 : b) * 6 * 1024;
        const int col0 = u.pn * 256 + wc * 32 + 8 * fq, rloc = wr * 64 + fr;
        f32x4 gv[2][2];
#pragma unroll
        for (int bj = 0; bj < 2; ++bj)
#pragma unroll
            for (int n = 0; n < 2; ++n) gv[bj][n] = *(const f32x4*)(gp + col0 + bj * 128 + 4 * n);
        const float* rf = xin ? (is_ctx ? cin + (size_t)(b * 256 + rloc) * 1024 : xin + (size_t)(b * 8192 + (pt - 1) * 256 + rloc) * 1024) : nullptr;
        bf16_t* xb = X + (size_t)(u.pm * 256 + rloc) * 1024;
        if (rf) {
#pragma unroll
            for (int am = 0; am < 4; ++am) { const int ai = am >> 1, mb = (am & 1) * 2;
                f32x4 r0[4][2], r1[4][2];
#pragma unroll
                for (int m = mb; m < mb + 2; ++m)
#pragma unroll
                    for (int bj = 0; bj < 2; ++bj) { const size_t ro = (size_t)(ai * 128 + m * 16) * 1024 + col0 + bj * 128; r0[m][bj] = *(const f32x4*)(rf + ro); r1[m][bj] = *(const f32x4*)(rf + ro + 4); }
                asm volatile("" ::: "memory");
#pragma unroll
                for (int m = mb; m < mb + 2; ++m)
#pragma unroll
                    for (int bj = 0; bj < 2; ++bj) { const size_t ro = (size_t)(ai * 128 + m * 16) * 1024 + col0 + bj * 128;
                        const f32x4 o0 = r0[m][bj] + gv[bj][0] * acc[ai][bj][m][0], o1 = r1[m][bj] + gv[bj][1] * acc[ai][bj][m][1];
                        u32x4 w; w.x = cvt_pk_bf16(o0[0], o0[1]); w.y = cvt_pk_bf16(o0[2], o0[3]); w.z = cvt_pk_bf16(o1[0], o1[1]); w.w = cvt_pk_bf16(o1[2], o1[3]);
                        *(u32x4*)(xb + ro) = w; }
            }
        } else {
#pragma unroll
            for (int ai = 0; ai < 2; ++ai) {
            u32x4 rw[2][4][2];
#pragma unroll
                for (int m = 0; m < 4; ++m)
#pragma unroll
                    for (int bj = 0; bj < 2; ++bj) rw[ai][m][bj] = *(const u32x4*)(xb + (size_t)(ai * 128 + m * 16) * 1024 + col0 + bj * 128);
            asm volatile("" ::: "memory");
#pragma unroll
                for (int m = 0; m < 4; ++m)
#pragma unroll
                    for (int bj = 0; bj < 2; ++bj) { const u32x4 w_ = rw[ai][m][bj];
                        const f32x4 r0 = (f32x4){__uint_as_float(w_.x << 16), __uint_as_float(w_.x & 0xffff0000u), __uint_as_float(w_.y << 16), __uint_as_float(w_.y & 0xffff0000u)};
                        const f32x4 r1 = (f32x4){__uint_as_float(w_.z << 16), __uint_as_float(w_.z & 0xffff0000u), __uint_as_float(w_.w << 16), __uint_as_float(w_.w & 0xffff0000u)};
                        const f32x4 o0 = r0 + gv[bj][0] * acc[ai][bj][m][0], o1 = r1 + gv[bj][1] * acc[ai][bj][m][1];
                        u32x4 w; w.x = cvt_pk_bf16(o0[0], o0[1]); w.y = cvt_pk_bf16(o0[2], o0[3]); w.z = cvt_pk_bf16(o1[0], o1[1]); w.w = cvt_pk_bf16(o1[2], o1[3]);
                        *(u32x4*)(xb + (size_t)(ai * 128 + m * 16) * 1024 + col0 + bj * 128) = w; }
            }
        }
    }
};

struct EpiSwiglu {
    static constexpr bool PERM = true, AFTER_DRAIN = false;
    bf16_t* G;
    __device__ __forceinline__ void operator()(const f32x4 (&acc)[2][2][4][2], const Unit& u, int wr, int wc, int fr, int fq) const {
        bf16_t* base = G + (size_t)(u.pm * 256 + wr * 64 + fr) * 2816 + u.pn * 128 + wc * 32 + 8 * fq;
#pragma unroll
        for (int ai = 0; ai < 2; ++ai)
#pragma unroll
            for (int m = 0; m < 4; ++m) { f32x4 o[2];
#pragma unroll
                for (int n = 0; n < 2; ++n) { const f32x4 g = acc[ai][0][m][n], up = acc[ai][1][m][n];
#pragma unroll
                    for (int j = 0; j < 4; ++j) o[n][j] = g[j] * __builtin_amdgcn_rcpf(1.0f + __builtin_amdgcn_exp2f(-1.4426950408889634f * g[j])) * up[j]; }
                u32x4 w; w.x = cvt_pk_bf16(o[0][0], o[0][1]); w.y = cvt_pk_bf16(o[0][2], o[0][3]); w.z = cvt_pk_bf16(o[1][0], o[1][1]); w.w = cvt_pk_bf16(o[1][2], o[1][3]);
                *(u32x4*)(base + (size_t)(ai * 128 + m * 16) * 2816) = w; }
    }
};

template <class Epi, class Sched, bool ALIGN_EPI = false, bool SP2 = false>
__device__ __forceinline__ void gemm_phase(PG8_LAS unsigned char* lds, const Gemm g, const Sched& S, const Epi& E) {
    int tid_o = threadIdx.x; asm volatile("" : "+v"(tid_o));
    const int tid = tid_o, wid = __builtin_amdgcn_readfirstlane(tid >> 6), lane = tid & 63, wr = wid >> 2, wc = wid & 3, fr = lane & 15, fq = lane >> 4;
    const int K = g.K, nt = K / BK;
    unsigned voffA[2], voffB[2];
#pragma unroll
    for (int i = 0; i < 2; ++i) { int R, C; stage_rc(tid * 16 + i * 8192, R, C); const int Rb = Epi::PERM ? ((R & ~31) + perm32(R & 31)) : R;
        voffA[i] = (unsigned)(R * K + C) * 2u; voffB[i] = (unsigned)(Rb * K + C) * 2u; }
    const size_t kstep = (size_t)(BK * 2);
    const size_t hstep = (size_t)HALF * K * 2;
    const size_t tstep = 2 * hstep;
    const unsigned ldsw = (unsigned)wid * 1024u;
    const int aoff = lds_byte(wr * 64 + fr, fq * 8), boff = lds_byte(wc * 32 + fr, fq * 8);
#define PG8_SA(b, h) (((b) * 2 + (h)) * HTB)
#define PG8_SB(b, h) ((4 + (b) * 2 + (h)) * HTB)
#define PG8_STAGE(bufoff, gbase, voff) do { _Pragma("unroll") for (int _i = 0; _i < 2; ++_i) \
        __builtin_amdgcn_global_load_lds((const unsigned*)((const char*)(gbase) + (voff)[_i]), (PG8_LAS unsigned*)(lds + (bufoff) + ldsw + _i * 8192), 16, 0, 0); } while (0)
#define PG8_LDA(dst, b, h) do { _Pragma("unroll") for (int m = 0; m < 4; ++m) _Pragma("unroll") for (int k = 0; k < 2; ++k) dst[m][k] = *(const PG8_LAS bf16x8*)(lds + PG8_SA(b, h) + aoff + m * 2048 + k * 1024); } while (0)
#define PG8_LDB(dst, b, h) do { _Pragma("unroll") for (int n = 0; n < 2; ++n) _Pragma("unroll") for (int k = 0; k < 2; ++k) dst[n][k] = *(const PG8_LAS bf16x8*)(lds + PG8_SB(b, h) + boff + n * 2048 + k * 1024); } while (0)
#define PG8_MMA(ai, bj, At, Bt) do { __builtin_amdgcn_s_setprio(1); _Pragma("unroll") for (int m = 0; m < 4; ++m) _Pragma("unroll") for (int n = 0; n < 2; ++n) _Pragma("unroll") for (int k = 0; k < 2; ++k) \
        acc[ai][bj][m][n] = __builtin_amdgcn_mfma_f32_16x16x32_bf16(Bt[n][k], At[m][k], acc[ai][bj][m][n], 0, 0, 0); __builtin_amdgcn_s_setprio(0); } while (0)
#define PG8_WAIT_V(n) asm volatile("s_waitcnt vmcnt(" #n ")" ::: "memory")
#define PG8_WAIT_L(n) asm volatile("s_waitcnt lgkmcnt(" #n ")" ::: "memory")
#define PG8_BAR __builtin_amdgcn_s_barrier()
#define PG8_SCHED __builtin_amdgcn_sched_barrier(0)
    Unit cur, nxt; int ui = 0;
    if (!S.next(0, cur)) return;
    f32x4 acc[2][2][4][2];
#pragma unroll
    for (int a = 0; a < 2; ++a)
#pragma unroll
        for (int b = 0; b < 2; ++b)
#pragma unroll
            for (int m = 0; m < 4; ++m)
#pragma unroll
                for (int n = 0; n < 2; ++n) acc[a][b][m][n] = (f32x4){0.f, 0.f, 0.f, 0.f};
    bf16x8 At[4][2], B0[2][2], B1[2][2];
    const char* cA = (const char*)g.A + (size_t)cur.pm * tstep; const char* cB = (const char*)g.Bt + (size_t)cur.pn * tstep;
    S.a_ready(cur);
    if constexpr (SP2) {
        PG8_STAGE(PG8_SB(0, 0), cB, voffB); PG8_STAGE(PG8_SB(0, 1), cB + hstep, voffB); PG8_STAGE(PG8_SA(0, 0), cA, voffA); PG8_STAGE(PG8_SA(0, 1), cA + hstep, voffA);
        if (wr == 1) PG8_BAR;
        PG8_WAIT_V(2); PG8_BAR;
        PG8_STAGE(PG8_SB(1, 0), cB + kstep, voffB); PG8_STAGE(PG8_SA(1, 0), cA + kstep, voffA); PG8_STAGE(PG8_SB(1, 1), cB + hstep + kstep, voffB);
        PG8_WAIT_V(6); PG8_BAR;
    } else {
        PG8_STAGE(PG8_SB(0, 0), cB, voffB); PG8_STAGE(PG8_SA(0, 0), cA, voffA); PG8_STAGE(PG8_SB(0, 1), cB + hstep, voffB); PG8_STAGE(PG8_SA(0, 1), cA + hstep, voffA);
        if (wr == 1) PG8_BAR;
        PG8_WAIT_V(4); PG8_BAR;
        PG8_STAGE(PG8_SB(1, 0), cB + kstep, voffB); PG8_STAGE(PG8_SA(1, 0), cA + kstep, voffA); PG8_STAGE(PG8_SB(1, 1), cB + hstep + kstep, voffB);
        PG8_WAIT_V(6); PG8_BAR;
    }
    for (;;) {
        const bool has_next = S.next(ui + 1, nxt);
        const char* nA = has_next ? (const char*)g.A + (size_t)nxt.pm * tstep : cA; const char* nB = has_next ? (const char*)g.Bt + (size_t)nxt.pn * tstep : cB;
        for (int t = 0; t < nt; t += 2) {
            const bool last = (t == nt - 2);
            const char* a1 = cA + (size_t)(t + 1) * kstep;
            const char* a2 = last ? nA : cA + (size_t)(t + 2) * kstep; const char* b2 = last ? nB : cB + (size_t)(t + 2) * kstep;
            const char* a3 = a2 + kstep; const char* b3 = b2 + kstep;
            if (last && has_next) S.a_ready(nxt);
            if constexpr (SP2) {
            PG8_LDB(B0, 0, 0); PG8_LDB(B1, 0, 1); PG8_SCHED; PG8_LDA(At, 0, 0); PG8_STAGE(PG8_SA(1, 1), a1 + hstep, voffA);
            PG8_WAIT_V(8); PG8_WAIT_L(0); PG8_BAR; PG8_MMA(0, 0, At, B0); PG8_MMA(0, 1, At, B1); PG8_BAR; PG8_SCHED;
            PG8_LDA(At, 0, 1); PG8_STAGE(PG8_SB(0, 0), b2, voffB); PG8_STAGE(PG8_SB(0, 1), b2 + hstep, voffB); PG8_STAGE(PG8_SA(0, 0), a2, voffA);
            PG8_WAIT_V(8); PG8_WAIT_L(0); PG8_BAR; PG8_MMA(1, 0, At, B0); PG8_MMA(1, 1, At, B1); PG8_BAR; PG8_SCHED;
            PG8_LDB(B0, 1, 0); PG8_LDB(B1, 1, 1); PG8_SCHED; PG8_LDA(At, 1, 0); PG8_STAGE(PG8_SA(0, 1), a2 + hstep, voffA);
            PG8_WAIT_V(8); PG8_WAIT_L(0); PG8_BAR; PG8_MMA(0, 0, At, B0); PG8_MMA(0, 1, At, B1); PG8_BAR; PG8_SCHED;
            PG8_LDA(At, 1, 1); PG8_STAGE(PG8_SB(1, 0), b3, voffB); PG8_STAGE(PG8_SB(1, 1), b3 + hstep, voffB); PG8_STAGE(PG8_SA(1, 0), a3, voffA);
            PG8_WAIT_V(8); PG8_WAIT_L(0); PG8_BAR; PG8_MMA(1, 0, At, B0); PG8_MMA(1, 1, At, B1); PG8_BAR; PG8_SCHED;
            } else {
            PG8_LDB(B0, 0, 0); PG8_SCHED; PG8_LDA(At, 0, 0); PG8_STAGE(PG8_SA(1, 1), a1 + hstep, voffA);
            PG8_WAIT_L(8); PG8_BAR; PG8_WAIT_L(0); PG8_MMA(0, 0, At, B0); PG8_BAR; PG8_SCHED;
            PG8_LDB(B1, 0, 1); PG8_STAGE(PG8_SB(0, 0), b2, voffB);
            PG8_BAR; PG8_WAIT_L(0); PG8_MMA(0, 1, At, B1); PG8_BAR;
            PG8_LDA(At, 0, 1); PG8_STAGE(PG8_SA(0, 0), a2, voffA);
            PG8_BAR; PG8_WAIT_L(0); PG8_MMA(1, 0, At, B0); PG8_BAR; PG8_SCHED;
            PG8_STAGE(PG8_SB(0, 1), b2 + hstep, voffB);
            PG8_WAIT_V(6); PG8_BAR; PG8_MMA(1, 1, At, B1); PG8_BAR;
            PG8_LDB(B0, 1, 0); PG8_SCHED; PG8_LDA(At, 1, 0); PG8_STAGE(PG8_SA(0, 1), a2 + hstep, voffA);
            PG8_WAIT_L(8); PG8_BAR; PG8_WAIT_L(0); PG8_MMA(0, 0, At, B0); PG8_BAR; PG8_SCHED;
            PG8_LDB(B1, 1, 1); PG8_STAGE(PG8_SB(1, 0), b3, voffB);
            PG8_BAR; PG8_WAIT_L(0); PG8_MMA(0, 1, At, B1); PG8_BAR;
            PG8_LDA(At, 1, 1); PG8_STAGE(PG8_SA(1, 0), a3, voffA);
            PG8_BAR; PG8_WAIT_L(0); PG8_MMA(1, 0, At, B0); PG8_BAR; PG8_SCHED;
            PG8_STAGE(PG8_SB(1, 1), b3 + hstep, voffB);
            PG8_WAIT_V(6); PG8_BAR; PG8_MMA(1, 1, At, B1); PG8_BAR;
            }
        }
        if constexpr (ALIGN_EPI) { if (wr == 0) PG8_BAR; }
        if constexpr (!Epi::AFTER_DRAIN) { E(acc, cur, wr, wc, fr, fq); S.done(cur); }
        if (!has_next) break;
#pragma unroll
        for (int a = 0; a < 2; ++a)
#pragma unroll
            for (int b = 0; b < 2; ++b)
#pragma unroll
                for (int m = 0; m < 4; ++m)
#pragma unroll
                    for (int n = 0; n < 2; ++n) acc[a][b][m][n] = (f32x4){0.f, 0.f, 0.f, 0.f};
        cur = nxt; cA = nA; cB = nB; ++ui;
        if constexpr (ALIGN_EPI) { if (wr == 1) PG8_BAR; }
    }
    PG8_WAIT_V(0);
    if constexpr (!ALIGN_EPI) { if (wr == 0) PG8_BAR; }
    PG8_BAR;
    if constexpr (Epi::AFTER_DRAIN) { E.fused(acc, cur, wr, wc, fr, fq, lds, wid, lane); S.done(cur); }
#undef PG8_SA
#undef PG8_SB
#undef PG8_STAGE
#undef PG8_LDA
#undef PG8_LDB
#undef PG8_MMA
#undef PG8_WAIT_V
#undef PG8_WAIT_L
#undef PG8_BAR
#undef PG8_SCHED
}
}
namespace attn_body {
using bf16=__hip_bfloat16;
using bf16x8=__attribute__((ext_vector_type(8)))short;
using s16x4=__attribute__((ext_vector_type(4)))short;
using f32x16=__attribute__((ext_vector_type(16)))float;
using u32x4=__attribute__((ext_vector_type(4)))unsigned;
constexpr int D=64,PQ=1280,PO=1024;
constexpr int NW=8,QBLK=32,QB=QBLK*NW,KVBLK=64;
constexpr int ATTN_UNIT_ROWS=QB;
__device__ __forceinline__ int crow(int r,int hi){return (r&3)+8*(r>>2)+4*hi;}
#define SBAR() __builtin_amdgcn_sched_barrier(0)
__device__ __forceinline__ void wmask(f32x16&p0,f32x16&p1,int dl,int hi){
  const float NEG=-INFINITY; const int kb=4*hi;
  #pragma unroll
  for(int r=0;r<16;++r){int kv=kb+(r&3)+8*(r>>2); if((unsigned)(dl-kv+128)>256u)p0[r]=NEG; if((unsigned)(dl-kv-32+128)>256u)p1[r]=NEG;}
}

constexpr int NSLOT=3, SLOTB=8192;
constexpr int LDS_K=0, LDS_V=NSLOT*SLOTB, LDS_WS=2*NSLOT*SLOTB, LDS_OST=LDS_WS+NW*64*4, LDS_BYTES=LDS_OST+NW*4096;
constexpr float C2=0.125f*1.4426950408889634f;
__device__ __forceinline__ void glds16(const void*gsrc,unsigned lds_dst){unsigned keep;
  asm volatile("s_mov_b32 %0, m0\n\ts_mov_b32 m0, %2\n\ts_nop 0\n\tglobal_load_lds_dwordx4 %1, off\n\ts_mov_b32 m0, %0":"=&s"(keep):"v"(gsrc),"s"(lds_dst):"memory");}
__device__ __forceinline__ float max3f(float a,float b,float c){float r;asm("v_max3_f32 %0, %1, %2, %3":"=v"(r):"v"(a),"v"(b),"v"(c));return r;}
__device__ __forceinline__ float max2f(float a,float b){float r;asm("v_max_f32_e32 %0, %1, %2":"=v"(r):"v"(a),"v"(b));return r;}
__device__ __forceinline__ float fadd_s(float a,float b){float r;asm("v_add_f32_e32 %0, %1, %2":"=v"(r):"v"(a),"v"(b));return r;}
__device__ __forceinline__ float fsub_s(float a,float b){float r;asm("v_sub_f32_e32 %0, %1, %2":"=v"(r):"v"(a),"v"(b));return r;}
typedef float f32x2_t __attribute__((ext_vector_type(2))); typedef __bf16 bf16x2_t __attribute__((ext_vector_type(2)));
__device__ __forceinline__ unsigned cvtpk_s(float lo,float hi){f32x2_t v={lo,hi};bf16x2_t b=__builtin_convertvector(v,bf16x2_t);return __builtin_bit_cast(unsigned,b);}
#define WAIT_BAR(N) asm volatile("s_waitcnt vmcnt(" #N ") lgkmcnt(0)\n\ts_barrier":::"memory")

__device__ __forceinline__ void qkt(f32x16&p0,f32x16&p1,const char*Kslot,const bf16x8*qr,const f32x16&negm,int r32,int hi){
  const char*kb=Kslot+hi*1024+r32*16;
  #pragma unroll
  for(int d0=0;d0<4;++d0){
    const bf16x8 b0=*reinterpret_cast<const bf16x8*>(kb+d0*2048);
    const bf16x8 b1=*reinterpret_cast<const bf16x8*>(kb+d0*2048+512);
    if(d0==0){p0=__builtin_amdgcn_mfma_f32_32x32x16_bf16(b0,qr[0],negm,0,0,0);p1=__builtin_amdgcn_mfma_f32_32x32x16_bf16(b1,qr[0],negm,0,0,0);}
    else{p0=__builtin_amdgcn_mfma_f32_32x32x16_bf16(b0,qr[d0],p0,0,0,0);p1=__builtin_amdgcn_mfma_f32_32x32x16_bf16(b1,qr[d0],p1,0,0,0);}}
}
typedef __attribute__((address_space(3))) const char* lds_cptr;
typedef short v4i16_t __attribute__((ext_vector_type(4)));
__device__ __forceinline__ void kload8(bf16x8*kf,lds_cptr kp){
  kf[0]=*(const __attribute__((address_space(3))) bf16x8*)(kp);      kf[1]=*(const __attribute__((address_space(3))) bf16x8*)(kp+512);
  kf[2]=*(const __attribute__((address_space(3))) bf16x8*)(kp+2048); kf[3]=*(const __attribute__((address_space(3))) bf16x8*)(kp+2560);
  kf[4]=*(const __attribute__((address_space(3))) bf16x8*)(kp+4096); kf[5]=*(const __attribute__((address_space(3))) bf16x8*)(kp+4608);
  kf[6]=*(const __attribute__((address_space(3))) bf16x8*)(kp+6144); kf[7]=*(const __attribute__((address_space(3))) bf16x8*)(kp+6656);
}
__device__ __forceinline__ void kload2(bf16x8*kf,lds_cptr kp,int j){ kf[2*j]=*(const __attribute__((address_space(3))) bf16x8*)(kp+j*2048); kf[2*j+1]=*(const __attribute__((address_space(3))) bf16x8*)(kp+j*2048+512); }
__device__ __forceinline__ s16x4 vtr(lds_cptr p){ return __builtin_bit_cast(s16x4,__builtin_amdgcn_ds_read_tr16_b64_v4i16((__attribute__((address_space(3))) v4i16_t*)p)); }
__device__ __forceinline__ float rowmax(const f32x16&p0,const f32x16&p1){
  float a=max3f(p0[0],p0[1],p1[0]),b=max3f(p0[2],p0[3],p1[1]);a=max3f(a,p1[2],p1[3]);
  #pragma unroll
  for(int r=4;r<16;r+=4){a=max3f(a,p0[r],p0[r+1]);b=max3f(b,p0[r+2],p0[r+3]);a=max3f(a,p1[r],p1[r+1]);b=max3f(b,p1[r+2],p1[r+3]);}
  const float m=max2f(a,b);
  auto rr=__builtin_amdgcn_permlane32_swap(__float_as_uint(m),__float_as_uint(m),false,false);
  return max2f(__uint_as_float(rr[0]),__uint_as_float(rr[1]));
}
__device__ __forceinline__ void pv(f32x16*o,int vb,bf16x8 pa0,bf16x8 pa1,bf16x8 pa2,bf16x8 pa3){
  #pragma unroll
  for(int d0=0;d0<2;++d0){s16x4 lo[4],hi[4];
    #pragma unroll
    for(int ks=0;ks<4;++ks){
      asm volatile("ds_read_b64_tr_b16 %0,%1 offset:%c2":"=&v"(lo[ks]):"v"(vb),"i"(d0*4096+ks*1024):"memory");
      asm volatile("ds_read_b64_tr_b16 %0,%1 offset:%c2":"=&v"(hi[ks]):"v"(vb),"i"(d0*4096+ks*1024+512):"memory");}
    asm volatile("s_waitcnt lgkmcnt(0)":::"memory");SBAR();
    #define PK(k) (bf16x8){lo[k][0],lo[k][1],lo[k][2],lo[k][3],hi[k][0],hi[k][1],hi[k][2],hi[k][3]}
    o[d0]=__builtin_amdgcn_mfma_f32_32x32x16_bf16(pa0,PK(0),o[d0],0,0,0);
    o[d0]=__builtin_amdgcn_mfma_f32_32x32x16_bf16(pa1,PK(1),o[d0],0,0,0);
    o[d0]=__builtin_amdgcn_mfma_f32_32x32x16_bf16(pa2,PK(2),o[d0],0,0,0);
    o[d0]=__builtin_amdgcn_mfma_f32_32x32x16_bf16(pa3,PK(3),o[d0],0,0,0);
    #undef PK
  }
}

#ifndef ATTN_STORE16
#define ATTN_STORE16(p,v) (*(u32x4*)(p)=(v))
#endif
template<int THRL,bool WIN,bool FIXM> __device__ __forceinline__ void attn_unit(const bf16*Qu,const bf16*__restrict__ Kh,const bf16*__restrict__ Vh,bf16*Ou,const int NT,const int boff,const int dq,const float sink_l2,const float mfix,char*shm){
  int tid_o=threadIdx.x; asm volatile("":"+v"(tid_o));
  const int tid=tid_o,lane=tid&63,r32=lane&31,hi=lane>>5; const int wid=__builtin_amdgcn_readfirstlane(tid>>6);
  const bf16*Qw=Qu+(long)(wid*QBLK)*PQ;
  const unsigned lds0=(unsigned)(uintptr_t)shm;
  float*wsf=(float*)(shm+LDS_WS)+wid*64;
  const bf16*ksrc=Kh+(long)lane*PQ+wid*8;
  const bf16*vsrc=Vh+(long)(16*(wid&3)+(lane>>2))*PQ+(wid>>2)*32+(lane&3)*8;
  const unsigned kdst=lds0+LDS_K+wid*1024, vdst=lds0+LDS_V+wid*1024;
  #define TROW(t) ((long)(KVBLK*(t)+((WIN&&(t)>=4)?boff:0)))
  #define DMA_K(t,slot) glds16(ksrc+TROW(t)*PQ,(unsigned)__builtin_amdgcn_readfirstlane(kdst+(slot)))
  #define DMA_V(t,slot) glds16(vsrc+TROW(t)*PQ,(unsigned)__builtin_amdgcn_readfirstlane(vdst+(slot)))
  const int vb0=(int)(lds0+LDS_V)+((lane>>4)&1)*32+(lane&3)*8+(4*hi+((lane&15)>>2))*64;
  const char*Kbase=shm+LDS_K; bf16x8 kf[8];
  const lds_cptr shm3=(lds_cptr)shm; const lds_cptr kp0=shm3+LDS_K+hi*1024+r32*16; const lds_cptr vp0=shm3+LDS_V+((lane>>4)&1)*32+(lane&3)*8+(4*hi+((lane&15)>>2))*64;
  DMA_K(0,0);DMA_V(0,0);DMA_K(1,SLOTB);
  bf16x8 qr[4];
  #pragma unroll
  for(int d0=0;d0<4;++d0)qr[d0]=*reinterpret_cast<const bf16x8*>(&Qw[(long)r32*PQ+d0*16+hi*8]);
  float mhat=FIXM?mfix:0.f,l_reg=0.f;asm volatile("":"+v"(mhat));
  f32x16 o[2];{float z_=0.f;asm volatile("":"+v"(z_));
  _Pragma("unroll") for(int r=0;r<16;++r){o[0][r]=z_;o[1][r]=z_;}}f32x16 negm;
  #pragma unroll
  for(int r=0;r<16;++r)negm[r]=-mhat;
  asm volatile("":"+v"(negm));
  const int dqrel=dq+wid*QBLK+r32;
  #define CMASK(P0,P1,t) do{ if(WIN){ if((t)>=4){ const int wb_=dq+wid*QBLK-KVBLK*((t)-4);     \
      if(wb_>97||wb_<-65) wmask(P0,P1,dqrel-KVBLK*((t)-4),hi); } } }while(0)
  bool resc=false;
  #define START(P0,P1) do{ resc=false; \
    if(!FIXM){ const float rm=rowmax(P0,P1); const float dl=rm; mhat=fadd_s(mhat,dl); \
      _Pragma("unroll") for(int r=0;r<16;++r){P0[r]=fsub_s(P0[r],dl);P1[r]=fsub_s(P1[r],dl);} \
      _Pragma("unroll") for(int r=0;r<16;++r)negm[r]=-mhat; asm volatile("":"+v"(negm)); } \
    _Pragma("unroll") for(int r=0;r<16;++r)P0[r]=__builtin_amdgcn_exp2f(P0[r]); }while(0)
  #define RESC() do{ if(resc){ asm volatile("s_waitcnt lgkmcnt(0)":::"memory"); \
      _Pragma("unroll") for(int d_=0;d_<2;++d_) _Pragma("unroll") for(int r=0;r<16;++r)o[d_][r]*=wsf[crow(r,hi)]; } }while(0)
  f32x16 pA0,pA1,pB0,pB1;
  int sl_prev=0,sl_cur=0,sl_next=SLOTB;
  #define ROT() do{sl_prev=sl_cur;sl_cur=sl_next;sl_next=(sl_next==(NSLOT-1)*SLOTB)?0:sl_next+SLOTB;}while(0)
  DMA_K(2,2*SLOTB);
  WAIT_BAR(3);
  qkt(pA0,pA1,Kbase,qr,negm,r32,hi);asm volatile("s_nop 15\n\ts_nop 7":"+v"(pA0),"+v"(pA1));CMASK(pA0,pA1,0);
  START(pA0,pA1);
  _Pragma("unroll") for(int r=0;r<16;++r)pA1[r]=__builtin_amdgcn_exp2f(pA1[r]);
  WAIT_BAR(0);
  DMA_K(3,0);DMA_V(1,SLOTB);
  ROT();
  kload8(kf,kp0+sl_cur);
  WAIT_BAR(2);
  s16x4 vlo[8],vhi[8]; u32x4 pw0,pw1,pw2,pw3;
  #define PKW(P,B) cvtpk_s(P[B],P[B+1])
  #define PAF(k) __builtin_bit_cast(bf16x8,pw##k)
  #define VFR(i) (bf16x8){vlo[i][0],vlo[i][1],vlo[i][2],vlo[i][3],vhi[i][0],vhi[i][1],vhi[i][2],vhi[i][3]}
  #define PIN(x) asm volatile("":"+v"(x))
  #define MX3(a,b,c) __builtin_fmaxf(__builtin_fmaxf((a),(b)),(c))
  #define GAPA(MF,A0,A1,A2,A3,W0,W1,PW) do{ MF; sacc+=A0; sacc+=A1; sacc+=A2; sacc+=A3; PIN(sacc); W0; W1; PIN(PW); SBAR(); }while(0)
  #define EX(v) __builtin_amdgcn_exp2f(v)
  #define GAPB(MF,X,B) do{ MF; X[B]=EX(X[B]); X[B+1]=EX(X[B+1]); X[B+2]=EX(X[B+2]); X[B+3]=EX(X[B+3]); PIN(X); SBAR(); }while(0)
  #define VRD(i) do{ vlo[i]=vtr(vp_+(((i)>>2)*4096+((i)&3)*1024)); vhi[i]=vtr(vp_+(((i)>>2)*4096+((i)&3)*1024+512)); }while(0)
  #define KRD(G,j) do{ if(G){ kload2(kf,kp0+sl_next,j); SBAR(); } }while(0)
  #define STEP(C0,C1,P0,P1,t,GK,GV,GL) do{ SBAR(); \
    const lds_cptr vp_=vp0+sl_prev; \
    VRD(0); SBAR(); float sacc=(P0[0]+P0[1]); \
    GAPA(C0=__builtin_amdgcn_mfma_f32_32x32x16_bf16(kf[0],qr[0],negm,0,0,0), P0[2],P0[3],P0[4],P0[5],     pw0[0]=PKW(P0,0), pw0[1]=PKW(P0,2), pw0); \
    VRD(4); SBAR(); GAPA(C1=__builtin_amdgcn_mfma_f32_32x32x16_bf16(kf[1],qr[0],negm,0,0,0), P0[6],P0[7],P0[8],P0[9],     pw0[2]=PKW(P0,4), pw0[3]=PKW(P0,6), pw0); \
    VRD(1); SBAR(); GAPA(C0=__builtin_amdgcn_mfma_f32_32x32x16_bf16(kf[2],qr[1],C0,0,0,0),   P0[10],P0[11],P0[12],P0[13], pw1[0]=PKW(P0,8), pw1[1]=PKW(P0,10), pw1); \
    VRD(5); SBAR(); GAPA(C1=__builtin_amdgcn_mfma_f32_32x32x16_bf16(kf[3],qr[1],C1,0,0,0),   P0[14],P0[15],P1[0],P1[1],   pw1[2]=PKW(P0,12),pw1[3]=PKW(P0,14), pw1); \
    VRD(2); SBAR(); GAPA(C0=__builtin_amdgcn_mfma_f32_32x32x16_bf16(kf[4],qr[2],C0,0,0,0),   P1[2],P1[3],P1[4],P1[5],     pw2[0]=PKW(P1,0), pw2[1]=PKW(P1,2), pw2); \
    VRD(6); SBAR(); GAPA(C1=__builtin_amdgcn_mfma_f32_32x32x16_bf16(kf[5],qr[2],C1,0,0,0),   P1[6],P1[7],P1[8],P1[9],     pw2[2]=PKW(P1,4), pw2[3]=PKW(P1,6), pw2); \
    VRD(3); SBAR(); GAPA(C0=__builtin_amdgcn_mfma_f32_32x32x16_bf16(kf[6],qr[3],C0,0,0,0),   P1[10],P1[11],P1[12],P1[13], pw3[0]=PKW(P1,8), pw3[1]=PKW(P1,10), pw3); \
    VRD(7); SBAR(); GAPA(C1=__builtin_amdgcn_mfma_f32_32x32x16_bf16(kf[7],qr[3],C1,0,0,0),   P1[14],P1[15],0.f,0.f,       pw3[2]=PKW(P1,12),pw3[3]=PKW(P1,14), pw3); \
    l_reg+=sacc; \
    if(GK){DMA_K((t)+3,sl_cur);} if(GV){DMA_V((t)+1,sl_next);} \
    CMASK(C0,C1,t); \
    if(!FIXM){ float a=MX3(C0[0],C0[1],C1[0]),b=MX3(C0[2],C0[3],C1[1]); a=MX3(a,C1[2],C1[3]); \
      _Pragma("unroll") for(int r=4;r<16;r+=4){a=MX3(a,C0[r],C0[r+1]);b=MX3(b,C0[r+2],C0[r+3]);a=MX3(a,C1[r],C1[r+1]);b=MX3(b,C1[r+2],C1[r+3]);} \
      float rm=__builtin_fmaxf(a,b); { auto rr=__builtin_amdgcn_permlane32_swap(__float_as_uint(rm),__float_as_uint(rm),false,false); rm=__builtin_fmaxf(__uint_as_float(rr[0]),__uint_as_float(rr[1])); } \
      resc=false; \
      if(__builtin_expect(__any(rm>(float)THRL),0)){ const float dl=__builtin_fmaxf(rm,0.f); mhat+=dl; \
        _Pragma("unroll") for(int r=0;r<16;++r){C0[r]-=dl;C1[r]-=dl;} \
        _Pragma("unroll") for(int r=0;r<16;++r)negm[r]=-mhat; asm volatile("":"+v"(negm)); \
        const float f=__builtin_amdgcn_exp2f(-dl); l_reg*=f; if(hi==0)wsf[r32]=f; resc=true; } } \
    SBAR(); \
    GAPB(o[0]=__builtin_amdgcn_mfma_f32_32x32x16_bf16(PAF(0),VFR(0),o[0],0,0,0), C0,0); \
    GAPB(o[1]=__builtin_amdgcn_mfma_f32_32x32x16_bf16(PAF(0),VFR(4),o[1],0,0,0), C0,4); \
    KRD(GL,0); GAPB(o[0]=__builtin_amdgcn_mfma_f32_32x32x16_bf16(PAF(1),VFR(1),o[0],0,0,0), C0,8); \
    KRD(GL,1); GAPB(o[1]=__builtin_amdgcn_mfma_f32_32x32x16_bf16(PAF(1),VFR(5),o[1],0,0,0), C0,12); \
    KRD(GL,2); GAPB(o[0]=__builtin_amdgcn_mfma_f32_32x32x16_bf16(PAF(2),VFR(2),o[0],0,0,0), C1,0); \
    KRD(GL,3); GAPB(o[1]=__builtin_amdgcn_mfma_f32_32x32x16_bf16(PAF(2),VFR(6),o[1],0,0,0), C1,4); \
    GAPB(o[0]=__builtin_amdgcn_mfma_f32_32x32x16_bf16(PAF(3),VFR(3),o[0],0,0,0), C1,8); \
    GAPB(o[1]=__builtin_amdgcn_mfma_f32_32x32x16_bf16(PAF(3),VFR(7),o[1],0,0,0), C1,12); \
    }while(0)
  int t=1;
  for(;t+5<NT;t+=2){
    STEP(pB0,pB1,pA0,pA1,t,true,true,true);     WAIT_BAR(2); RESC(); ROT();
    STEP(pA0,pA1,pB0,pB1,t+1,true,true,true);   WAIT_BAR(2); RESC(); ROT();
  }
  #define ENDW(tt) do{ if((tt)+3<NT){WAIT_BAR(2);} else if((tt)+2<NT){WAIT_BAR(1);} else {WAIT_BAR(0);} }while(0)
  for(;t+1<NT;t+=2){
    STEP(pB0,pB1,pA0,pA1,t,(t+3<NT),(t+1<NT),(t+1<NT));       ENDW(t);   RESC(); ROT();
    STEP(pA0,pA1,pB0,pB1,t+1,(t+4<NT),(t+2<NT),(t+2<NT));     ENDW(t+1); RESC(); ROT();
  }
  STEP(pB0,pB1,pA0,pA1,NT-1,false,false,false); RESC();
  { float sacc=pB0[0]+pB0[1]; _Pragma("unroll") for(int r=2;r<16;++r)sacc+=pB0[r]; _Pragma("unroll") for(int r=0;r<16;++r)sacc+=pB1[r]; l_reg+=sacc;
    pw0=(u32x4){PKW(pB0,0),PKW(pB0,2),PKW(pB0,4),PKW(pB0,6)};pw1=(u32x4){PKW(pB0,8),PKW(pB0,10),PKW(pB0,12),PKW(pB0,14)};pw2=(u32x4){PKW(pB1,0),PKW(pB1,2),PKW(pB1,4),PKW(pB1,6)};pw3=(u32x4){PKW(pB1,8),PKW(pB1,10),PKW(pB1,12),PKW(pB1,14)};
    SBAR(); pv(o,vb0+sl_cur,PAF(0),PAF(1),PAF(2),PAF(3)); }
  #undef PKW
  #undef PAF
  #undef VFR
  #undef PIN
  #undef MX3
  #undef GAPA
  #undef GAPB
  #undef EX
  #undef VRD
  #undef KRD
  #undef STEP
  #undef ENDW
  {auto rr=__builtin_amdgcn_permlane32_swap(__float_as_uint(l_reg),__float_as_uint(l_reg),false,false);l_reg=__uint_as_float(rr[0])+__uint_as_float(rr[1]);}
  l_reg+=__builtin_amdgcn_exp2f(sink_l2-mhat);
  if(hi==0)wsf[32+r32]=l_reg;asm volatile("s_waitcnt lgkmcnt(0)":::"memory");
  float rli[16];
  #pragma unroll
  for(int r=0;r<16;++r)rli[r]=__builtin_amdgcn_rcpf(wsf[32+crow(r,hi)]);
  bf16*Ow=Ou+(long)(wid*QBLK)*PO;
  { bf16*stg=(bf16*)(shm+LDS_OST)+wid*2048;
    #pragma unroll
    for(int r=0;r<16;++r){const int orow=crow(r,hi);
      #pragma unroll
      for(int d0=0;d0<2;++d0)stg[orow*64+d0*32+r32]=__float2bfloat16(o[d0][r]*rli[r]);}
    asm volatile("s_waitcnt lgkmcnt(0)":::"memory");
    #pragma unroll
    for(int i=0;i<4;++i){const int row=i*8+(lane>>3),ch=lane&7; const u32x4 v=*(const u32x4*)(stg+row*64+ch*8); ATTN_STORE16(Ow+(long)row*PO+ch*8,v);} }
  asm volatile("s_waitcnt lgkmcnt(0)\n\ts_barrier":::"memory");
  #undef TROW
  #undef DMA_K
  #undef DMA_V
  #undef CMASK
  #undef START
  #undef RESC
  #undef ROT
}
constexpr int ATTN_LDS_BYTES=LDS_BYTES;
#undef SBAR
#undef WAIT_BAR
}
namespace cg = cooperative_groups;
#define LAS __attribute__((address_space(3)))
typedef unsigned short u16;
typedef unsigned v4u __attribute__((ext_vector_type(4)));
typedef float f32x4 __attribute__((ext_vector_type(4)));
#define LDS_WAIT() asm volatile("s_waitcnt lgkmcnt(0)" ::: "memory")
#define XB_TMO      128
#define XB_XCNT(j)  (256  + 64 * (j))
#define XB_XSUB(j)  (1280 + 64 * (j))
#define XB_XGEN(j)  (2304 + 64 * (j))
#define XB_TOP      3328
#define XB_TOPGEN   3392
#define XCD_BAR_WORDS 3456
#define XB_SPIN_CAP (1u << 18)

__device__ __forceinline__ unsigned xb_ld(unsigned* p)              { return __hip_atomic_load(p, __ATOMIC_RELAXED, __HIP_MEMORY_SCOPE_AGENT); }
__device__ __forceinline__ unsigned xb_add(unsigned* p, unsigned v) { return __hip_atomic_fetch_add(p, v, __ATOMIC_RELAXED, __HIP_MEMORY_SCOPE_AGENT); }
__device__ __forceinline__ unsigned xb_xcc_id() { return (unsigned)__builtin_amdgcn_s_getreg((3 << 11) | 20) & 0xFu; }
#define XB_SPIN(cond, bar) do { unsigned _sp = 0; while (cond) { __builtin_amdgcn_s_sleep(1); \
    if ((++_sp & 255u) == 0u) { if (xb_ld(&(bar)[XB_TMO])) break; if (_sp > XB_SPIN_CAP) { atomicAdd(&(bar)[XB_TMO], 1u); break; } } } } while (0)

struct XcdBarrier {
    unsigned* bar; unsigned x;
    volatile LAS unsigned* st;
};

__device__ __forceinline__ XcdBarrier xcd_barrier_post(unsigned* bar, volatile LAS unsigned* st) {
    XcdBarrier b; b.bar = bar; b.x = xb_xcc_id(); b.st = st;
    if (threadIdx.x == 0) (void)xb_add(&bar[XB_XCNT(b.x)], 1u);
    return b;
}
__device__ __forceinline__ void xcd_barrier_complete(unsigned* bar, unsigned x, unsigned& nloc, unsigned& nx) {
    const unsigned G = gridDim.x * gridDim.y * gridDim.z;
    unsigned sum, cnt, mine, sp = 0u;
    for (;;) {
        sum = 0u; cnt = 0u; mine = 0u;
#pragma unroll
        for (unsigned j = 0; j < 16; ++j) { const unsigned c = xb_ld(&bar[XB_XCNT(j)]); sum += c; cnt += (c > 0u) ? 1u : 0u; mine = (j == x) ? c : mine; }
        if (sum == G) break;
        __builtin_amdgcn_s_sleep(1);
        if ((++sp & 255u) == 0u) { if (xb_ld(&bar[XB_TMO])) break; if (sp > XB_SPIN_CAP) { atomicAdd(&bar[XB_TMO], 1u); break; } }
    }
    nloc = mine > 0u ? mine : 1u; nx = cnt > 0u ? cnt : 1u;
}

__device__ __forceinline__ void xcd_barrier(const XcdBarrier& b) {
    asm volatile("s_waitcnt vmcnt(0)" ::: "memory");
    __syncthreads();
    if (threadIdx.x == 0) {
        unsigned* bar = b.bar;
        __builtin_amdgcn_s_waitcnt(0);
        unsigned nloc = b.st[0], nx = b.st[1];
        if (nloc == 0u) { xcd_barrier_complete(bar, b.x, nloc, nx); b.st[0] = nloc; b.st[1] = nx; }
        const unsigned old = xb_add(&bar[XB_XSUB(b.x)], 1u);
        const unsigned gen = old / nloc;
        if (old + 1u == (gen + 1u) * nloc) {
            __builtin_amdgcn_fence(__ATOMIC_RELEASE, "agent");
            asm volatile("s_waitcnt vmcnt(0)" ::: "memory");
            const unsigned og = xb_add(&bar[XB_TOP], 1u);
            const unsigned tg = og / nx;
            if (og + 1u == (tg + 1u) * nx) xb_add(&bar[XB_TOPGEN], 1u);
            else XB_SPIN(xb_ld(&bar[XB_TOPGEN]) == tg, bar);
            __builtin_amdgcn_fence(__ATOMIC_ACQUIRE, "agent");
            xb_add(&bar[XB_XGEN(b.x)], 1u);
            asm volatile("s_waitcnt vmcnt(0)" ::: "memory");
        } else {
            XB_SPIN(xb_ld(&bar[XB_XGEN(b.x)]) == gen, bar);
            __builtin_amdgcn_fence(__ATOMIC_ACQUIRE, "agent");
            asm volatile("s_waitcnt vmcnt(0)" ::: "memory");
        }
    }
    __syncthreads();
}


constexpr int NWAVES = 8, NTHREADS = NWAVES * 64;
constexpr int DM = 1024, NB = 8, SEQ = 8192, CTX = 256, BR = SEQ + CTX, MROWS = NB * BR, NIN = 1792, PQW = 1280, FF = 2816, NGU = 2 * FF;
constexpr size_t MiB = 1u << 20;
constexpr size_t WS_PART = 1 * MiB;
constexpr size_t WS_MOD = 8 * MiB;
constexpr size_t WS_TC = 9 * MiB;
constexpr size_t WS_ROPE = 10 * MiB;
constexpr size_t WS_W = 12 * MiB, W_LAYER = 22 * MiB, W_IN = 0, W_OUT = 3 * MiB + 512 * 1024, W_GU = W_OUT + 2 * MiB, W_DN = W_GU + 11 * MiB;
constexpr size_t WS_G = 56 * MiB;
constexpr size_t WS_P = WS_G, WS_O = WS_P + 165 * MiB, WS_UT = WS_O + 132 * MiB, WS_UTC = WS_UT + 64 * MiB;
constexpr size_t WS_H = WS_G + 363 * MiB;
constexpr size_t WS_X = WS_H + 132 * MiB;
constexpr size_t WS_UF = WS_X + 264 * MiB;
constexpr size_t WS_END = WS_UF + 64 * MiB;
static_assert(WS_W + 2 * W_LAYER <= WS_G && WS_UTC + 2 * MiB <= WS_H && W_DN + 5 * MiB + 512 * 1024 <= W_LAYER, "d_ws map");
constexpr int RING_BYTES = 131072, LDS_BYTES = 147456;

struct Args { const float* in[17]; float* out; unsigned char* ws; };

__device__ __forceinline__ float wave_sum(float v) {
    v = pg8::lane_xor_add<1>(v); v = pg8::lane_xor_add<2>(v); v = pg8::lane_xor_add<4>(v); v = pg8::lane_xor_add<8>(v); v = pg8::lane_xor_add<16>(v); v = pg8::lane_xor_add<32>(v);
    return v;
}
__device__ __forceinline__ unsigned pk2(float lo, float hi) { return pg8::cvt_pk_bf16(lo, hi); }

__device__ __forceinline__ void tr_item(const float* W, int K, int N, u16* WT, int k0, int n0, int drow0, LAS float* scr, int lane) {
#pragma unroll 8
    for (int i = 0; i < 32; ++i) { const int kk = 2 * i + (lane >> 5); scr[kk * 33 + (lane & 31)] = W[(size_t)(k0 + kk) * N + n0 + (lane & 31)]; }
    LDS_WAIT(); asm volatile("" ::: "memory");
    const int c = lane & 7;
#pragma unroll
    for (int j = 0; j < 4; ++j) { const int n = (lane >> 3) + 8 * j; const LAS float* s = scr + (8 * c) * 33 + n;
        v4u o; o.x = pk2(s[0 * 33], s[1 * 33]); o.y = pk2(s[2 * 33], s[3 * 33]); o.z = pk2(s[4 * 33], s[5 * 33]); o.w = pk2(s[6 * 33], s[7 * 33]);
        *(v4u*)(WT + (size_t)(drow0 + n) * K + k0 + 8 * c) = o; }
    LDS_WAIT(); asm volatile("" ::: "memory");
}
__device__ __forceinline__ void fmix_item(const float* Win, u16* WinT, int item, LAS float* scr, int lane) {
    const int g = item & 3, k0 = (item >> 2) * 32;
    LAS float* tabc = scr + 32 * 65; LAS float* tabs = tabc + 64;
    tabc[lane] = __builtin_amdgcn_cosf((float)lane * (1.0f / 64.0f)); tabs[lane] = __builtin_amdgcn_sinf((float)lane * (1.0f / 64.0f));
#pragma unroll 8
    for (int i = 0; i < 32; ++i) scr[i * 65 + lane] = Win[(size_t)(k0 + i) * 1536 + 640 + g * 64 + lane];
    LDS_WAIT(); asm volatile("" ::: "memory");
    float ac[32], as[32];
#pragma unroll
    for (int kk = 0; kk < 32; ++kk) { ac[kk] = 0.f; as[kk] = 0.f; }
#pragma unroll 2
    for (int c = 0; c < 64; ++c) { const int ti = (c * lane) & 63; const float tc = tabc[ti], ts = tabs[ti];
#pragma unroll
        for (int kk = 0; kk < 32; ++kk) { const float w = scr[kk * 65 + c]; ac[kk] += w * tc; as[kk] += w * ts; } }
    const int drow = 128 * (lane >> 5) + 32 * g + (lane & 31);
    u16* dc = WinT + (size_t)(1280 + drow) * 1024 + k0; u16* ds = WinT + (size_t)(1536 + drow) * 1024 + k0;
#pragma unroll
    for (int q = 0; q < 4; ++q) {
        v4u o; o.x = pk2(ac[8 * q], ac[8 * q + 1]); o.y = pk2(ac[8 * q + 2], ac[8 * q + 3]); o.z = pk2(ac[8 * q + 4], ac[8 * q + 5]); o.w = pk2(ac[8 * q + 6], ac[8 * q + 7]);
        *(v4u*)(dc + 8 * q) = o;
        v4u p; p.x = pk2(as[8 * q], as[8 * q + 1]); p.y = pk2(as[8 * q + 2], as[8 * q + 3]); p.z = pk2(as[8 * q + 4], as[8 * q + 5]); p.w = pk2(as[8 * q + 6], as[8 * q + 7]);
        *(v4u*)(ds + 8 * q) = p; }
    LDS_WAIT(); asm volatile("" ::: "memory");
}
__device__ __forceinline__ void ada_item(const float* c, const float* c_ctx, const float* w_ada, float* part, int item, LAS float* scr, int lane) {
    const int cb = item % 96, s = (item / 96) & 15, l = item / (96 * 16);
#pragma unroll
    for (int r = 0; r < 9; ++r) { const float v = (r < 8) ? c[r * 1024 + s * 64 + lane] : c_ctx[s * 64 + lane]; scr[r * 64 + lane] = v / (1.0f + __expf(-v)); }
    LDS_WAIT(); asm volatile("" ::: "memory");
    float acc[9];
#pragma unroll
    for (int r = 0; r < 9; ++r) acc[r] = 0.f;
    const float* wp = w_ada + (size_t)l * 1024 * 6144 + (size_t)(s * 64) * 6144 + cb * 64 + lane;
#pragma unroll 8
    for (int kk = 0; kk < 64; ++kk) { const float w = wp[(size_t)kk * 6144];
#pragma unroll
        for (int r = 0; r < 9; ++r) acc[r] += scr[r * 64 + kk] * w; }
#pragma unroll
    for (int r = 0; r < 9; ++r) part[((size_t)(s * 2 + l) * 9 + r) * 6144 + cb * 64 + lane] = acc[r];
    LDS_WAIT(); asm volatile("" ::: "memory");
}

__device__ __forceinline__ void norm_row_bf16(const float* xrow, const float* A, const float* B, u16* orow, int lane) {
    const f32x4* xr = (const f32x4*)xrow + lane; const f32x4* ar = (const f32x4*)A + lane; const f32x4* br = (const f32x4*)B + lane;
    f32x4 v[4]; float s = 0.f;
#pragma unroll
    for (int j = 0; j < 4; ++j) { v[j] = xr[64 * j]; s += (v[j].x * v[j].x + v[j].y * v[j].y) + (v[j].z * v[j].z + v[j].w * v[j].w); }
    const float rstd = 1.0f / sqrtf(wave_sum(s) * (1.0f / 1024.0f) + 1e-6f);
    unsigned long long* o8 = (unsigned long long*)orow + lane;
#pragma unroll
    for (int j = 0; j < 4; ++j) { const f32x4 y = v[j] * rstd * ar[64 * j] + br[64 * j];
        o8[64 * j] = (unsigned long long)pk2(y.x, y.y) | ((unsigned long long)pk2(y.z, y.w) << 32); }
}

__device__ __forceinline__ void conv_weights(const float* w_in_, const float* w_out_, const float* w_gate_, const float* w_up_, const float* w_down_, u16* wbase, int l, int gwx, int ngwx, LAS float* scr, int lane) {
    constexpr int I_IN = 16 * 40, I_OUT = 16 * 32, I_GT = 16 * 88, I_DN = 44 * 32, I_LAYER = I_IN + I_OUT + 2 * I_GT + I_DN;
    u16* wl = wbase + (size_t)l * (W_LAYER / 2);
    for (int it = gwx; it < I_LAYER; it += ngwx) { int r = it;
        if (r < I_IN) { const int kb = r / 40, nb0 = r % 40, nb = nb0 < 20 ? nb0 : nb0 + 8;
            const int n0 = nb * 32, slot = n0 < 640 ? n0 / 64 : (n0 - 896) / 64 + 10, bj = (n0 & 63) >> 5;
            tr_item(w_in_ + (size_t)l * 1024 * 1536, 1024, 1536, wl + W_IN / 2, kb * 64, n0, 256 * (slot >> 2) + 128 * bj + 32 * (slot & 3), scr, lane); continue; }
        r -= I_IN;
        if (r < I_OUT) { const int kb = r / 32, nb = r % 32; tr_item(w_out_ + (size_t)l * 1024 * 1024, 1024, 1024, wl + W_OUT / 2, kb * 64, nb * 32, nb * 32, scr, lane); continue; }
        r -= I_OUT;
        if (r < 2 * I_GT) { const int up = r / I_GT; r %= I_GT; const int kb = r / 88, nb = r % 88, n0 = nb * 32;
            tr_item((up ? w_up_ : w_gate_) + (size_t)l * 1024 * FF, 1024, FF, wl + W_GU / 2, kb * 64, n0, 256 * (n0 >> 7) + 128 * up + (n0 & 127), scr, lane); continue; }
        r -= 2 * I_GT;
        { const int kb = r / 32, nb = r % 32; tr_item(w_down_ + (size_t)l * FF * 1024, FF, 1024, wl + W_DN / 2, kb * 64, nb * 32, nb * 32, scr, lane); }
    }
    for (int it = gwx; it < 128; it += ngwx) fmix_item(w_in_ + (size_t)l * 1024 * 1536, wl + W_IN / 2, it, scr, lane);
}

__device__ constexpr float FFT_C32[16] = {1.000000000f, 0.980785280f, 0.923879533f, 0.831469612f, 0.707106781f, 0.555570233f, 0.382683432f, 0.195090322f, 0.000000000f, -0.195090322f, -0.382683432f, -0.555570233f, -0.707106781f, -0.831469612f, -0.923879533f, -0.980785280f};
__device__ constexpr float FFT_S32[16] = {0.000000000f, 0.195090322f, 0.382683432f, 0.555570233f, 0.707106781f, 0.831469612f, 0.923879533f, 0.980785280f, 1.000000000f, 0.980785280f, 0.923879533f, 0.831469612f, 0.707106781f, 0.555570233f, 0.382683432f, 0.195090322f};
template <int HALF> __device__ __forceinline__ void fft32_stage(float (&xr)[32], float (&xi)[32]) {
#pragma unroll
    for (int blk = 0; blk < 32; blk += 2 * HALF)
#pragma unroll
        for (int j = 0; j < HALF; ++j) { const int i0 = blk + j, i1 = i0 + HALF, m = j * (16 / HALF);
            const float tr = xr[i0] - xr[i1], ti = xi[i0] - xi[i1]; xr[i0] += xr[i1]; xi[i0] += xi[i1];
            if (m == 0) { xr[i1] = tr; xi[i1] = ti; }
            else if (m == 8) { xr[i1] = ti; xi[i1] = -tr; }
            else { const float c = FFT_C32[m], s = FFT_S32[m]; xr[i1] = tr * c + ti * s; xi[i1] = ti * c - tr * s; } }
}
__device__ __forceinline__ constexpr int bitrev5(int k) { return ((k & 1) << 4) | ((k & 2) << 2) | (k & 4) | ((k & 8) >> 2) | ((k & 16) >> 4); }
__device__ __forceinline__ void fft32_item(const u16* utrow, u16* Zb, int b, int n, int l2) {
    unsigned wre[32], wim[32], ox[32], oy[32];
#pragma unroll
    for (int j = 0; j < 32; ++j) { wre[j] = *(const unsigned*)(utrow + 256 * j + l2); wim[j] = *(const unsigned*)(utrow + 8192 + 256 * j + l2); }
#pragma unroll
    for (int h = 0; h < 2; ++h) {
        float xr[32], xi[32];
#pragma unroll
        for (int j = 0; j < 32; ++j) { xr[j] = __uint_as_float(h ? (wre[j] & 0xffff0000u) : (wre[j] << 16)); xi[j] = -__uint_as_float(h ? (wim[j] & 0xffff0000u) : (wim[j] << 16)); }
        fft32_stage<16>(xr, xi); fft32_stage<8>(xr, xi); fft32_stage<4>(xr, xi); fft32_stage<2>(xr, xi); fft32_stage<1>(xr, xi);
#pragma unroll
        for (int k1 = 0; k1 < 32; ++k1) { const float yx = xr[bitrev5(k1)], yy = xi[bitrev5(k1)];
            const float rev = (float)((k1 * (l2 + h)) & 8191) * (1.0f / 8192.0f); const float ca = __builtin_amdgcn_cosf(rev), sa = __builtin_amdgcn_sinf(rev);
            const float zx = yx * ca + yy * sa, zy = yy * ca - yx * sa;
            if (h == 0) { ox[k1] = pk2(zx, 0.f); oy[k1] = pk2(-zy, 0.f); } else { ox[k1] |= pk2(0.f, zx); oy[k1] |= pk2(0.f, -zy); } }
    }
#pragma unroll
    for (int k1 = 0; k1 < 32; ++k1) { u16* zp = Zb + ((size_t)((b * 32 + k1) * 256 + n)) * 512 + l2; *(unsigned*)zp = ox[k1]; *(unsigned*)(zp + 256) = oy[k1]; }
}

template <bool FINAL, bool SRC16> __device__ __forceinline__ void norm4_rows(const void* x0v, const float* A, const float* B, void* o0, int lane) {
    f32x4 v[4][4]; float s[4];
#pragma unroll
    for (int r = 0; r < 4; ++r)
#pragma unroll
        for (int j = 0; j < 4; ++j) {
            if (SRC16) { typedef unsigned u32x2 __attribute__((ext_vector_type(2))); const u32x2 w = ((const u32x2*)((const u16*)x0v + (size_t)r * 1024))[lane + 64 * j];
                v[r][j] = (f32x4){__uint_as_float(w.x << 16), __uint_as_float(w.x & 0xffff0000u), __uint_as_float(w.y << 16), __uint_as_float(w.y & 0xffff0000u)}; }
            else v[r][j] = ((const f32x4*)((const float*)x0v + (size_t)r * 1024))[lane + 64 * j]; }
#pragma unroll
    for (int r = 0; r < 4; ++r) { s[r] = 0.f;
#pragma unroll
        for (int j = 0; j < 4; ++j) s[r] += (v[r][j].x * v[r][j].x + v[r][j].y * v[r][j].y) + (v[r][j].z * v[r][j].z + v[r][j].w * v[r][j].w); }
#pragma unroll
    for (int r = 0; r < 4; ++r) { s[r] = pg8::lane_xor_add<1>(s[r]); s[r] = pg8::lane_xor_add<2>(s[r]); s[r] = pg8::lane_xor_add<4>(s[r]); s[r] = pg8::lane_xor_add<8>(s[r]); s[r] = pg8::lane_xor_add<16>(s[r]); s[r] = pg8::lane_xor_add<32>(s[r]); }
    f32x4 a[4], b[4];
#pragma unroll
    for (int j = 0; j < 4; ++j) { a[j] = ((const f32x4*)A)[lane + 64 * j]; b[j] = FINAL ? (f32x4){0.f, 0.f, 0.f, 0.f} : ((const f32x4*)B)[lane + 64 * j]; }
#pragma unroll
    for (int r = 0; r < 4; ++r) { const float rstd = 1.0f / sqrtf(s[r] * (1.0f / 1024.0f) + 1e-6f);
#pragma unroll
        for (int j = 0; j < 4; ++j) { const f32x4 y = v[r][j] * rstd * a[j] + b[j];
            if (FINAL) ((f32x4*)((float*)o0 + (size_t)r * 1024))[lane + 64 * j] = y;
            else ((unsigned long long*)((u16*)o0 + (size_t)r * 1024))[lane + 64 * j] = (unsigned long long)pk2(y.x, y.y) | ((unsigned long long)pk2(y.z, y.w) << 32); } }
}

__global__ void __launch_bounds__(NTHREADS, 2) hybrid_fwd(Args args) {
    extern __shared__ __attribute__((aligned(16))) unsigned char lds[];
    cg::grid_group grid = cg::this_grid();
    LAS unsigned char* ldsA = (LAS unsigned char*)lds;
#define PH_BASE() size_t wz_ = 0; asm volatile("" : "+s"(wz_)); unsigned char* ws = args.ws + wz_; int G = gridDim.x; asm volatile("" : "+s"(G)); int bx = blockIdx.x; asm volatile("" : "+s"(bx)); \
    const int vcu = (G % 8 == 0) ? (bx % 8) * (G / 8) + bx / 8 : bx; const int NGW = G * NWAVES, NGT = NGW * 64; (void)vcu; (void)NGT; (void)NGW
#define PH_IDS() int tid_o = threadIdx.x; asm volatile("" : "+v"(tid_o)); const int lane = tid_o & 63, wave = __builtin_amdgcn_readfirstlane(tid_o >> 6), gw = vcu * NWAVES + wave, gtid = gw * 64 + lane; (void)gtid; (void)gw
#define x_in (args.in[0])
#define c_in (args.in[1])
#define ctx_in (args.in[2])
#define cctx_in (args.in[3])
#define w_ada (args.in[4])
#define b_ada (args.in[5])
#define g_mix (args.in[6])
#define g_ffn (args.in[7])
#define w_in (args.in[8])
#define q_norm (args.in[9])
#define k_norm (args.in[10])
#define sink (args.in[11])
#define w_out (args.in[12])
#define w_gate (args.in[13])
#define w_up (args.in[14])
#define w_down (args.in[15])
#define g_final (args.in[16])
#define PART ((float*)(ws + WS_PART))
#define MOD ((float*)(ws + WS_MOD))
#define TC ((u16*)(ws + WS_TC))
#define ROPE ((float*)(ws + WS_ROPE))
#define Pb ((u16*)(ws + WS_P))
#define Ob ((u16*)(ws + WS_O))
#define UT ((u16*)(ws + WS_UT))
#define UTC ((u16*)(ws + WS_UTC))
#define Gb ((u16*)(ws + WS_G))
#define Hb ((u16*)(ws + WS_H))
#define X ((u16*)(ws + WS_X))
#define UF ((u16*)(ws + WS_UF))
#define FLAGS ((unsigned*)ws)
#define WL ((const u16*)(ws + WS_W + (size_t)l * W_LAYER))
#define MODL (MOD + (size_t)l * 9 * 6 * 1024)
#define GRID_BAR() do { XcdBarrier b_; b_.bar = (unsigned*)args.ws + 1024; b_.x = xb_xcc_id(); b_.st = (volatile LAS unsigned*)(ldsA + RING_BYTES + 64); xcd_barrier(b_); } while (0)

    {
        PH_BASE(); PH_IDS();
        LAS float* scr = (LAS float*)(ldsA + wave * 16384);
        if (bx == 0) { if (tid_o < 2) __hip_atomic_store(FLAGS + 64 * tid_o, 0u, __ATOMIC_RELAXED, __HIP_MEMORY_SCOPE_AGENT);
            for (int w = tid_o; w < XCD_BAR_WORDS; w += NTHREADS) __hip_atomic_store(FLAGS + 1024 + w, 0u, __ATOMIC_RELAXED, __HIP_MEMORY_SCOPE_AGENT); }
        if (tid_o < 2) ((volatile LAS unsigned*)(ldsA + RING_BYTES + 64))[tid_o] = 0u;
        for (int it = gw; it < 2 * 16 * 96; it += NGW) ada_item(c_in, cctx_in, w_ada, PART, it, scr, lane);
        for (int idx = gtid; idx < 256 * 64; idx += NGT) { const int k = idx >> 6, kk0 = (idx & 63) << 3; const bool sn = kk0 >= 256; const int l0 = kk0 & 255;
            float v[8];
#pragma unroll
            for (int j = 0; j < 8; ++j) { const float rev = (float)((k * (l0 + j)) & 255) * (1.0f / 256.0f); v[j] = sn ? -__builtin_amdgcn_sinf(rev) : __builtin_amdgcn_cosf(rev); }
            v4u o; o.x = pk2(v[0], v[1]); o.y = pk2(v[2], v[3]); o.z = pk2(v[4], v[5]); o.w = pk2(v[6], v[7]);
            *(v4u*)(TC + (size_t)idx * 8) = o; }
    }
    grid.sync();
    (void)xcd_barrier_post((unsigned*)args.ws + 1024, (volatile LAS unsigned*)(ldsA + RING_BYTES + 64));
    { PH_BASE(); PH_IDS();
    for (int idx = gtid; idx < 2 * 9 * 1024; idx += NGT) { const int col = idx & 1023, r = (idx >> 10) % 9, l = idx / 9216;
        float m[6];
#pragma unroll
        for (int w = 0; w < 6; ++w) { float a = b_ada[l * 6144 + w * 1024 + col];
            for (int s = 0; s < 16; ++s) a += PART[((size_t)(s * 2 + l) * 9 + r) * 6144 + w * 1024 + col];
            m[w] = a; }
        float* o = MOD + (size_t)((l * 9 + r) * 6) * 1024 + col;
        o[0] = g_mix[l * 1024 + col] * (1.0f + m[1]); o[1024] = m[0]; o[2048] = m[2];
        o[3072] = g_ffn[l * 1024 + col] * (1.0f + m[4]); o[4096] = m[3]; o[5120] = m[5]; }
    }
    GRID_BAR();

#pragma nounroll
    for (int l = 0; l < 2; ++l) {
        { PH_BASE(); PH_IDS();
        if (l == 0) {
            LAS float* scr = (LAS float*)(ldsA + wave * 16384);
            conv_weights(w_in, w_out, w_gate, w_up, w_down, (u16*)(ws + WS_W), 0, gw, NGW, scr, lane);
            for (int row = 4 * gw; row < MROWS; row += 4 * NGW) { const int b = row / BR, p = row % BR; const bool is_ctx = p < CTX; const int r = is_ctx ? 8 : b;
                norm4_rows<false, false>(is_ctx ? ctx_in + (size_t)(b * CTX + p) * DM : x_in + (size_t)(b * SEQ + p - CTX) * DM, MODL + (size_t)(r * 6 + 0) * 1024, MODL + (size_t)(r * 6 + 1) * 1024, Hb + (size_t)row * DM, lane); }
        } else {
            for (int q = gw; q < NB * CTX / 4; q += NGW) { const int row = (q >> 6) * BR + (q & 63) * 4;
                norm4_rows<false, true>(X + (size_t)row * DM, MODL + (size_t)(8 * 6 + 0) * 1024, MODL + (size_t)(8 * 6 + 1) * 1024, Hb + (size_t)row * DM, lane); }
        } }
        GRID_BAR();
#pragma nounroll
        for (int sp = 0; sp < 2; ++sp) {
            PH_BASE();
            if (sp == 1 && bx >= 56) { PH_IDS(); const int gw2 = (bx - 56) * NWAVES + wave, NGW2 = (G - 56) * NWAVES;
                for (int it = gw2; it < 2048 * 2; it += NGW2) { const int bn = it >> 1, l2 = ((it & 1) << 7) + 2 * lane;
                    fft32_item(UT + (size_t)bn * 16384, UF, bn >> 8, bn & 255, l2); } }
            else { pg8::Gemm g{Hb, WL + W_IN / 2, MROWS, NIN, DM}; pg8::RowOrder S; S.init(NIN, G, bx, sp == 0 ? 1 : 2);
                pg8::EpiInProj E{Pb, UT, UTC, q_norm + l * 64, k_norm + l * 64};
                pg8::gemm_phase<pg8::EpiInProj, pg8::RowOrder, true, true>(ldsA, g, S, E); }
            GRID_BAR();
        }
        {
            PH_BASE();
            const int pair = vcu >> 4, jj = vcu & 15, b = pair >> 1, kvh = pair & 1;
            const attn_body::bf16* Pa = (const attn_body::bf16*)Pb; attn_body::bf16* Oa = (attn_body::bf16*)Ob;
            const int cid = ((vcu & 31) != 0) ? (vcu & 31) - 1 + 31 * (vcu >> 5) : 1000;
            const int nA = 6 + ((l == 0 && cid < 96) ? 1 : 0);
            float mfix; { float gq = 0.f, gk = 0.f;
#pragma unroll 8
                for (int j = 0; j < 64; ++j) { gq = __builtin_fmaxf(gq, __builtin_fabsf(q_norm[l * 64 + j])); gk = __builtin_fmaxf(gk, __builtin_fabsf(k_norm[l * 64 + j])); }
                mfix = __uint_as_float(__builtin_amdgcn_readfirstlane(__float_as_uint(64.0f * 1.02f * 0.125f * 1.4426950408889634f * gq * gk))); }
            const bool fixm = mfix <= 48.0f;
#pragma nounroll
            for (int i = 0; i < nA; ++i) {
                const attn_body::bf16 *Qu, *Kh, *Vh; attn_body::bf16* Ou; int NT; float sk = -INFINITY;
                if (i < 6) { const int idx = i * 16 + jj, hq = kvh * 3 + (idx >> 5), qb = idx & 31; const size_t r0 = (size_t)b * BR;
                    Qu = Pa + (r0 + CTX + qb * 256) * PQW + hq * 64; Kh = Pa + r0 * PQW + (6 + kvh) * 64; Vh = Pa + r0 * PQW + (8 + kvh) * 64; Ou = Oa + (r0 + CTX + qb * 256) * 1024 + hq * 64; NT = 132; }
                else { const int ty = cid / 48, rem = cid % 48, cb = rem / 6, hq = rem % 6, ckv = hq / 3; const size_t r0 = (size_t)cb * BR;
                    const int qc = ty ? 10 + hq : hq, kc = ty ? 16 + ckv : 6 + ckv, vc = ty ? 18 + ckv : 8 + ckv, oc = ty ? 640 + hq * 64 : hq * 64;
                    Qu = Pa + r0 * PQW + qc * 64; Kh = Pa + r0 * PQW + kc * 64; Vh = Pa + r0 * PQW + vc * 64; Ou = Oa + r0 * 1024 + oc; NT = 4;
                    if (ty) sk = sink[l * 6 + hq] * 1.4426950408889634f; }
#ifndef NO_ATTN_A
                if (i < 6 && fixm) attn_body::attn_unit<8, false, true>(Qu, Kh, Vh, Ou, NT, 0, 0, sk, mfix, (char*)lds);
                else attn_body::attn_unit<8, false, false>(Qu, Kh, Vh, Ou, NT, 0, 0, sk, 0.f, (char*)lds);
#endif
            }
#pragma nounroll
            for (int i = 0; i < 6; ++i) {
                const int idx = i * 16 + jj, hq = kvh * 3 + (idx >> 5), qb = idx & 31, q0 = qb * 256; const size_t r0 = (size_t)b * BR;
                const int kb0 = q0 >= 128 ? q0 - 128 : 0, ke = q0 + 384 <= SEQ ? q0 + 384 : SEQ, NT = 4 + (ke - kb0) / 64;
#ifndef NO_ATTN_W
                attn_body::attn_unit<8, true, false>(Pa + (r0 + CTX + q0) * PQW + (10 + hq) * 64, Pa + r0 * PQW + (16 + kvh) * 64, Pa + r0 * PQW + (18 + kvh) * 64,
                                              Oa + (r0 + CTX + q0) * 1024 + 640 + hq * 64, NT, kb0, q0 - kb0, sink[l * 6 + hq] * 1.4426950408889634f, 0.f, (char*)lds);
#endif
            }
            __syncthreads();
            const int nF = (l == 0) ? 2 : 1;
#pragma nounroll
            for (int v = 0; v < nF; ++v) {
                pg8::Gemm g = v == 0 ? pg8::Gemm{TC, UF, 256, 65536, 512} : pg8::Gemm{TC, UTC, 256, 2048, 512};
                pg8::StaticOrder S; S.init(g.M, g.N, G, bx);
                pg8::EpiFourier E{Ob, v == 0 ? 1 : 0, v == 0 ? 0.001381067932004976f : 0.0078125f};
                pg8::gemm_phase<pg8::EpiFourier, pg8::StaticOrder, true, true>(ldsA, g, S, E);
                __syncthreads();
            }
        }
        GRID_BAR();
        { PH_BASE(); pg8::Gemm g{Ob, WL + W_OUT / 2, MROWS, DM, DM}; pg8::RowOrder S; S.init(DM, G, bx, l == 1);
          pg8::EpiResid E{l == 0 ? x_in : nullptr, l == 0 ? ctx_in : nullptr, X, MODL + 2 * 1024};
          pg8::gemm_phase<pg8::EpiResid, pg8::RowOrder, true, true>(ldsA, g, S, E); }
        GRID_BAR();
        { PH_BASE(); PH_IDS();
        for (int row = 4 * gw; row < MROWS; row += 4 * NGW) { const int b = row / BR, p = row % BR; const bool is_ctx = p < CTX; const int r = is_ctx ? 8 : b;
            if (l == 1 && is_ctx) continue;
            norm4_rows<false, true>(X + (size_t)row * DM, MODL + (size_t)(r * 6 + 3) * 1024, MODL + (size_t)(r * 6 + 4) * 1024, Hb + (size_t)row * DM, lane); } }
        GRID_BAR();
#pragma nounroll
        for (int hb = 0; hb < (l == 1 ? 2 : 1); ++hb) {
        { PH_BASE(); pg8::Gemm g{Hb, WL + W_GU / 2, MROWS, NGU, DM}; pg8::RowOrder S; S.init(NGU, G, bx, l == 1 ? 3 + hb : 0);
          pg8::EpiSwiglu E{Gb};
          pg8::gemm_phase<pg8::EpiSwiglu, pg8::RowOrder, true, true>(ldsA, g, S, E); }
        GRID_BAR();
        { const int nsp = (l == 0) ? 2 : 1;
#pragma nounroll
          for (int sp = 0; sp < nsp; ++sp) {
            PH_BASE();
            if (sp == 1 && bx >= 32) { PH_IDS(); const int gw2 = (bx - 32) * NWAVES + wave, NGW2 = (G - 32) * NWAVES;
                for (int q = gw2; q < NB * SEQ / 4; q += NGW2) { const int b = q >> 11, row = b * BR + CTX + ((q & 2047) << 2);
                    norm4_rows<false, true>(X + (size_t)row * DM, MOD + (size_t)((9 + b) * 6 + 0) * 1024, MOD + (size_t)((9 + b) * 6 + 1) * 1024, Hb + (size_t)row * DM, lane); }
                conv_weights(w_in, w_out, w_gate, w_up, w_down, (u16*)(ws + WS_W), 1, gw2, NGW2, (LAS float*)(ldsA + wave * 16384), lane); }
            else { pg8::Gemm g{Gb, WL + W_DN / 2, MROWS, DM, FF}; pg8::RowOrder S; S.init(DM, G, bx, sp == 0 ? (l == 1 ? 3 + hb : 1) : 2);
                pg8::EpiResid E{nullptr, nullptr, X, MODL + 5 * 1024};
                pg8::gemm_phase<pg8::EpiResid, pg8::RowOrder, true, true>(ldsA, g, S, E); }
            GRID_BAR();
          } }
        }
    }
    { PH_BASE(); PH_IDS();
    for (int row = 4 * gw; row < NB * SEQ; row += 4 * NGW) { const int b = row >> 13, t = row & 8191;
        norm4_rows<true, true>(X + (size_t)(b * BR + CTX + t) * DM, g_final, nullptr, args.out + (size_t)row * DM, lane); } }
}

extern "C" void kernel_launch(void* const* d_in, const int* in_sizes, int n_in, void* d_out, int out_size, void* d_ws, size_t ws_size, hipStream_t stream) {
    static int grid = 0;
    if (grid == 0) {
        if (n_in != 17 || in_sizes[0] != NB * SEQ * DM || out_size != NB * SEQ * DM || ws_size < WS_END) {
            fprintf(stderr, "kernel_launch: unexpected shapes (n_in %d, in0 %d, out %d, ws %zu, need %zu); nothing launched\n", n_in, n_in > 0 ? in_sizes[0] : -1, out_size, ws_size, (size_t)WS_END); grid = -1; return; }
        int dev = 0, cus = 0, per_cu = 0;
        if (hipGetDevice(&dev) != hipSuccess || hipDeviceGetAttribute(&cus, hipDeviceAttributeMultiprocessorCount, dev) != hipSuccess) { fprintf(stderr, "kernel_launch: device query failed\n"); grid = -1; return; }
        if (hipFuncSetAttribute((const void*)hybrid_fwd, hipFuncAttributeMaxDynamicSharedMemorySize, LDS_BYTES) != hipSuccess) { fprintf(stderr, "kernel_launch: hipFuncSetAttribute failed\n"); grid = -1; return; }
        if (hipOccupancyMaxActiveBlocksPerMultiprocessor(&per_cu, (const void*)hybrid_fwd, NTHREADS, LDS_BYTES) != hipSuccess || per_cu < 1) { fprintf(stderr, "kernel_launch: occupancy query says %d blocks per CU\n", per_cu); per_cu = 1; }
        (void)hipGetLastError();
        grid = cus;
        if (grid != 256) fprintf(stderr, "kernel_launch: %d CUs; the mixer phase's static schedule assumes 256\n", grid);
    }
    if (grid < 0) return;
    Args a{};
    for (int i = 0; i < 17; ++i) a.in[i] = (const float*)d_in[i];
    a.out = (float*)d_out; a.ws = (unsigned char*)d_ws;
    void* kargs[] = {&a};
    const hipError_t e = hipLaunchCooperativeKernel((const void*)hybrid_fwd, dim3(grid), dim3(NTHREADS), kargs, LDS_BYTES, stream);
    if (e != hipSuccess) fprintf(stderr, "kernel_launch: cooperative launch failed: %s (grid %d)\n", hipGetErrorString(e), grid);
}
```

```cpp
#include <hip/hip_runtime.h>
#include <hip/hip_cooperative_groups.h>
#include <cstdio>
#include <cstdint>
#include <hip/hip_bf16.h>
#include <cmath>
namespace pg8 {
#define PG8_LAS __attribute__((address_space(3)))
typedef unsigned short bf16_t;
typedef short bf16x8 __attribute__((ext_vector_type(8)));
typedef float f32x4 __attribute__((ext_vector_type(4)));
typedef unsigned u32x4 __attribute__((ext_vector_type(4)));
constexpr int BM = 256, BK = 64, HALF = 128, HTB = HALF * BK * 2  , STAGE_BYTES = 8 * HTB, NXCD = 8, WGM = 8;

__host__ __device__ __forceinline__ int lds_byte(int r, int c) { const int st = (r >> 4) * 2 + (c >> 5), rr = r & 15, cc = c & 31, ob = rr * 64 + cc * 2; return st * 1024 + (ob ^ (((ob >> 9) & 1) << 5)); }
__host__ __device__ __forceinline__ void stage_rc(int b, int& R, int& C) { const int st = b / 1024, sb = b % 1024, swz = sb ^ (((sb >> 9) & 1) << 5); R = (st >> 1) * 16 + swz / 64; C = (st & 1) * 32 + (swz % 64) / 2; }
__host__ __device__ __forceinline__ int perm32(int rho) { const int n = rho >> 4, i = rho & 15; return 8 * (i >> 2) + 4 * n + (i & 3); }

struct Unit { int pm, pn; };
struct Gemm { const bf16_t* A; const bf16_t* Bt; int M, N, K; };

struct StaticOrder {
    int nM, nN, nwg, G, c;
    __host__ __device__ void init(int M, int N, int G_, int c_) { nM = M / BM; nN = N / BM; nwg = nM * nN; G = G_; c = c_; }
    __host__ __device__ bool next(int i, Unit& u) const {
        const long L = (long)i * G + c; if (L >= nwg) return false;
        int wgid = (int)L; { const int q = nwg / NXCD, r = nwg % NXCD, xcd = wgid % NXCD, off = wgid / NXCD; wgid = (xcd < r ? xcd * (q + 1) : r * (q + 1) + (xcd - r) * q) + off; }
        const int nig = WGM * nN, gid = wgid / nig, fm = gid * WGM, gsz = (nM - fm) < WGM ? (nM - fm) : WGM;
        u.pm = fm + ((wgid % nig) % gsz); u.pn = (wgid % nig) / gsz; return true;
    }
    __device__ __forceinline__ void a_ready(const Unit&) const {}
    __device__ __forceinline__ void done(const Unit&) const {}
};

__device__ __forceinline__ unsigned cvt_pk_bf16(float lo, float hi) { unsigned r; asm volatile("v_cvt_pk_bf16_f32 %0, %1, %2" : "=v"(r) : "v"(lo), "v"(hi)); return r; }
typedef float f32x2 __attribute__((ext_vector_type(2)));
template <int XM> __device__ __forceinline__ float lane_xor_add(float v) {
    if constexpr (XM == 32) { const auto rr = __builtin_amdgcn_permlane32_swap(__float_as_uint(v), __float_as_uint(v), false, false); return __uint_as_float(rr[0]) + __uint_as_float(rr[1]); }
    else return v + __uint_as_float((unsigned)__builtin_amdgcn_ds_swizzle((int)__float_as_uint(v), (XM << 10) | 0x1f));
}
typedef unsigned u32x4 __attribute__((ext_vector_type(4)));
constexpr float QK_C2 = 0.125f * 1.4426950408889634f;
constexpr int BR_TILES = 33;

struct RowOrder {
    StaticOrder s; int mode, nn;
    __host__ __device__ void init(int N, int G_, int c_, int mode_) { mode = mode_; nn = N / BM; s.init(mode_ == 1 ? 65536 : 67584, N, G_, c_); }
    __host__ __device__ bool next(int i, Unit& u) const {
        if (mode == 2) { if (i != 0 || s.c >= 8 * nn) return false; u.pm = (s.c / nn) * 33; u.pn = s.c % nn; return true; }
        if (!s.next(i, u)) return false; if (mode == 1) u.pm = u.pm + (u.pm >> 5) + 1; return true; }
    __device__ __forceinline__ void a_ready(const Unit&) const {}
    __device__ __forceinline__ void done(const Unit&) const {}
};

struct EpiInProj {
    static constexpr bool PERM = true, AFTER_DRAIN = false;
    bf16_t* P; bf16_t* UT; bf16_t* UTc; const float* qn; const float* kn;
    __device__ __forceinline__ void operator()(const f32x4 (&acc)[2][2][4][2], const Unit& u, int wr, int wc, int fr, int fq) const {
        const int b = u.pm / BR_TILES, pt = u.pm % BR_TILES; const bool is_ctx = (pt == 0);
        const int slot = u.pn * 4 + wc;
        const int rloc = wr * 64 + fr;
        if (slot >= 20) {
            const int g = slot - 20, qi = fr & 3; const bool r1 = (fr & 1) != 0, h1 = (fr & 2) != 0;
            const unsigned selB = r1 ? 0x03020706u : 0x05040100u;
            bf16_t* base; size_t pitch;
            if (is_ctx) { base = UTc + (size_t)(b * 256 + g * 64) * 256 + (rloc - qi); pitch = 256; }
            else { base = UT + (size_t)(b * 256 + g * 64) * 8192 + (pt - 1) * 256 + (rloc - qi); pitch = 8192; }
            typedef unsigned u32x2 __attribute__((ext_vector_type(2)));
#pragma unroll
            for (int ai = 0; ai < 2; ++ai)
#pragma unroll
                for (int m = 0; m < 4; ++m)
#pragma unroll
                    for (int bj = 0; bj < 2; ++bj)
#pragma unroll
                        for (int n = 0; n < 2; ++n) { const f32x4 v = acc[ai][bj][m][n]; const unsigned w0 = cvt_pk_bf16(v[0], v[1]), w1 = cvt_pk_bf16(v[2], v[3]);
                            const unsigned snd = h1 ? w0 : w1, rcv = (unsigned)__builtin_amdgcn_update_dpp(0, (int)snd, 0x4E, 0xF, 0xF, true);
                            const unsigned a0 = h1 ? rcv : w0, a1 = h1 ? w1 : rcv;
                            const unsigned p0 = (unsigned)__builtin_amdgcn_update_dpp(0, (int)a0, 0xB1, 0xF, 0xF, true), p1 = (unsigned)__builtin_amdgcn_update_dpp(0, (int)a1, 0xB1, 0xF, 0xF, true);
                            u32x2 x; x.x = __builtin_amdgcn_perm(p0, a0, selB); x.y = __builtin_amdgcn_perm(p1, a1, selB);
                            *(u32x2*)(base + (size_t)(32 * bj + 8 * fq + 4 * n + qi) * pitch + ai * 128 + m * 16) = x; }
            return;
        }
        const bool isq = slot < 6 || (slot >= 10 && slot < 16);
        const bool isk = slot == 6 || slot == 7 || slot == 16 || slot == 17;
        const bool donorm = slot < 8;
        const bool dorope = (isq || isk) && !is_ctx;
        const float* gam = slot < 6 ? qn : kn;
        f32x4 gv[2][2];
#pragma unroll
        for (int bj = 0; bj < 2; ++bj)
#pragma unroll
            for (int n = 0; n < 2; ++n) gv[bj][n] = donorm ? *(const f32x4*)(gam + 32 * bj + 8 * fq + 4 * n) : (f32x4){1.f, 1.f, 1.f, 1.f};
        const float qs = isq ? QK_C2 : 1.f;
        bf16_t* orow0 = P + (size_t)(u.pm * 256 + rloc) * 1280 + slot * 64 + 8 * fq;
        float rf[2][4];
#pragma unroll
        for (int n = 0; n < 2; ++n)
#pragma unroll
            for (int j = 0; j < 4; ++j) rf[n][j] = __builtin_amdgcn_exp2f(-(float)((8 * fq + 4 * n + j) & 15) * (13.287712379549449f / 16.0f)) * 0.15915494309189535f;
        const int tl0 = (pt - 1) * 256 + rloc;
#pragma unroll
        for (int ai = 0; ai < 2; ++ai)
#pragma unroll
            for (int m = 0; m < 4; ++m) {
                f32x4 v[2][2];
#pragma unroll
                for (int bj = 0; bj < 2; ++bj)
#pragma unroll
                    for (int n = 0; n < 2; ++n) v[bj][n] = acc[ai][bj][m][n];
                if (donorm) {
                    float ss = 0.f;
#pragma unroll
                    for (int bj = 0; bj < 2; ++bj)
#pragma unroll
                        for (int n = 0; n < 2; ++n) ss += (v[bj][n][0] * v[bj][n][0] + v[bj][n][1] * v[bj][n][1]) + (v[bj][n][2] * v[bj][n][2] + v[bj][n][3] * v[bj][n][3]);
                    ss = lane_xor_add<16>(ss); ss = lane_xor_add<32>(ss);
                    const float rs = 1.0f / sqrtf(ss * (1.0f / 64.0f) + 1e-6f);
#pragma unroll
                    for (int bj = 0; bj < 2; ++bj)
#pragma unroll
                        for (int n = 0; n < 2; ++n) v[bj][n] = v[bj][n] * rs * gv[bj][n];
                }
                if (dorope) {
                    const int tl = tl0 + ai * 128 + m * 16; const float fp = (float)(fq >= 2 ? (tl & 63) : (tl >> 6));
#pragma unroll
                    for (int n = 0; n < 2; ++n) {
                        f32x4 cc, sn;
#pragma unroll
                        for (int j = 0; j < 4; ++j) { const float rev = __builtin_amdgcn_fractf(fp * rf[n][j]); cc[j] = __builtin_amdgcn_cosf(rev); sn[j] = __builtin_amdgcn_sinf(rev); }
                        const f32x4 x1 = v[0][n], x2 = v[1][n];
                        v[0][n] = x1 * cc - x2 * sn; v[1][n] = x2 * cc + x1 * sn;
                    }
                }
#pragma unroll
                for (int bj = 0; bj < 2; ++bj) {
                    const f32x4 v0 = v[bj][0] * qs, v1 = v[bj][1] * qs;
                    u32x4 w; w.x = cvt_pk_bf16(v0[0], v0[1]); w.y = cvt_pk_bf16(v0[2], v0[3]); w.z = cvt_pk_bf16(v1[0], v1[1]); w.w = cvt_pk_bf16(v1[2], v1[3]);
                    *(u32x4*)(orow0 + (size_t)(ai * 128 + m * 16) * 1280 + 32 * bj) = w;
                }
            }
    }
};

struct EpiFourier {
    static constexpr bool PERM = true, AFTER_DRAIN = false;
    bf16_t* O; int mode; float scale;
    __device__ __forceinline__ void operator()(const f32x4 (&acc)[2][2][4][2], const Unit& u, int wr, int wc, int fr, int fq) const {
        const size_t row0 = mode ? (size_t)(u.pn >> 5) * 8448 + 256 + (u.pn & 31) : (size_t)u.pn * 8448; const int rstride = mode ? 32 : 1;
        bf16_t* base = O + row0 * 1024 + 384 + wc * 32 + 8 * fq;
#pragma unroll
        for (int ai = 0; ai < 2; ++ai)
#pragma unroll
            for (int m = 0; m < 4; ++m) { bf16_t* rowp = base + (size_t)((ai * 128 + wr * 64 + m * 16 + fr) * rstride) * 1024;
#pragma unroll
                for (int bj = 0; bj < 2; ++bj) { const f32x4 v0 = acc[ai][bj][m][0] * scale, v1 = acc[ai][bj][m][1] * scale;
                    u32x4 w; w.x = cvt_pk_bf16(v0[0], v0[1]); w.y = cvt_pk_bf16(v0[2], v0[3]); w.z = cvt_pk_bf16(v1[0], v1[1]); w.w = cvt_pk_bf16(v1[2], v1[3]);
                    *(u32x4*)(rowp + bj * 128) = w; } }
    }
};

struct EpiResid {
    static constexpr bool PERM = true, AFTER_DRAIN = false;
    const float* xin; const float* cin;
    bf16_t* X; const float* gate;
    __device__ __forceinline__ void operator()(const f32x4 (&acc)[2][2][4][2], const Unit& u, int wr, int wc, int fr, int fq) const {
        const int b = u.pm / BR_TILES, pt = u.pm % BR_TILES; const bool is_ctx = (pt == 0);
        const float* gp = gate + (size_t)(is_ctx ? 8 : b) * 6 * 1024;
        const int col0 = u.pn * 256 + wc * 32 + 8 * fq, rloc = wr * 64 + fr;
        f32x4 gv[2][2];
#pragma unroll
        for (int bj = 0; bj < 2; ++bj)
#pragma unroll
            for (int n = 0; n < 2; ++n) gv[bj][n] = *(const f32x4*)(gp + col0 + bj * 128 + 4 * n);
        const float* rf = xin ? (is_ctx ? cin + (size_t)(b * 256 + rloc) * 1024 : xin + (size_t)(b * 8192 + (pt - 1) * 256 + rloc) * 1024) : nullptr;
        bf16_t* xb = X + (size_t)(u.pm * 256 + rloc) * 1024;
        if (rf) {
#pragma unroll
            for (int am = 0; am < 4; ++am) { const int ai = am >> 1, mb = (am & 1) * 2;
                f32x4 r0[4][2], r1[4][2];
#pragma unroll
                for (int m = mb; m < mb + 2; ++m)
#pragma unroll
                    for (int bj = 0; bj < 2; ++bj) { const size_t ro = (size_t)(ai * 128 + m * 16) * 1024 + col0 + bj * 128; r0[m][bj] = *(const f32x4*)(rf + ro); r1[m][bj] = *(const f32x4*)(rf + ro + 4); }
                asm volatile("" ::: "memory");
#pragma unroll
                for (int m = mb; m < mb + 2; ++m)
#pragma unroll
                    for (int bj = 0; bj < 2; ++bj) { const size_t ro = (size_t)(ai * 128 + m * 16) * 1024 + col0 + bj * 128;
                        const f32x4 o0 = r0[m][bj] + gv[bj][0] * acc[ai][bj][m][0], o1 = r1[m][bj] + gv[bj][1] * acc[ai][bj][m][1];
                        u32x4 w; w.x = cvt_pk_bf16(o0[0], o0[1]); w.y = cvt_pk_bf16(o0[2], o0[3]); w.z = cvt_pk_bf16(o1[0], o1[1]); w.w = cvt_pk_bf16(o1[2], o1[3]);
                        *(u32x4*)(xb + ro) = w; }
            }
        } else {
#pragma unroll
            for (int ai = 0; ai < 2; ++ai) {
            u32x4 rw[2][4][2];
#pragma unroll
                for (int m = 0; m < 4; ++m)
#pragma unroll
                    for (int bj = 0; bj < 2; ++bj) rw[ai][m][bj] = *(const u32x4*)(xb + (size_t)(ai * 128 + m * 16) * 1024 + col0 + bj * 128);
            asm volatile("" ::: "memory");
#pragma unroll
                for (int m = 0; m < 4; ++m)
#pragma unroll
                    for (int bj = 0; bj < 2; ++bj) { const u32x4 w_ = rw[ai][m][bj];
                        const f32x4 r0 = (f32x4){__uint_as_float(w_.x << 16), __uint_as_float(w_.x & 0xffff0000u), __uint_as_float(w_.y << 16), __uint_as_float(w_.y & 0xffff0000u)};
                        const f32x4 r1 = (f32x4){__uint_as_float(w_.z << 16), __uint_as_float(w_.z & 0xffff0000u), __uint_as_float(w_.w << 16), __uint_as_float(w_.w & 0xffff0000u)};
                        const f32x4 o0 = r0 + gv[bj][0] * acc[ai][bj][m][0], o1 = r1 + gv[bj][1] * acc[ai][bj][m][1];
                        u32x4 w; w.x = cvt_pk_bf16(o0[0], o0[1]); w.y = cvt_pk_bf16(o0[2], o0[3]); w.z = cvt_pk_bf16(o1[0], o1[1]); w.w = cvt_pk_bf16(o1[2], o1[3]);
                        *(u32x4*)(xb + (size_t)(ai * 128 + m * 16) * 1024 + col0 + bj * 128) = w; }
            }
        }
    }
};

struct EpiSwiglu {
    static constexpr bool PERM = true, AFTER_DRAIN = false;
    bf16_t* G;
    __device__ __forceinline__ void operator()(const f32x4 (&acc)[2][2][4][2], const Unit& u, int wr, int wc, int fr, int fq) const {
        bf16_t* base = G + (size_t)(u.pm * 256 + wr * 64 + fr) * 2816 + u.pn * 128 + wc * 32 + 8 * fq;
#pragma unroll
        for (int ai = 0; ai < 2; ++ai)
#pragma unroll
            for (int m = 0; m < 4; ++m) { f32x4 o[2];
#pragma unroll
                for (int n = 0; n < 2; ++n) { const f32x4 g = acc[ai][0][m][n], up = acc[ai][1][m][n];
#pragma unroll
                    for (int j = 0; j < 4; ++j) o[n][j] = g[j] * __builtin_amdgcn_rcpf(1.0f + __builtin_amdgcn_exp2f(-1.4426950408889634f * g[j])) * up[j]; }
                u32x4 w; w.x = cvt_pk_bf16(o[0][0], o[0][1]); w.y = cvt_pk_bf16(o[0][2], o[0][3]); w.z = cvt_pk_bf16(o[1][0], o[1][1]); w.w = cvt_pk_bf16(o[1][2], o[1][3]);
                *(u32x4*)(base + (size_t)(ai * 128 + m * 16) * 2816) = w; }
    }
};

template <class Epi, class Sched, bool ALIGN_EPI = false, bool SP2 = false>
__device__ __forceinline__ void gemm_phase(PG8_LAS unsigned char* lds, const Gemm g, const Sched& S, const Epi& E) {
    int tid_o = threadIdx.x; asm volatile("" : "+v"(tid_o));
    const int tid = tid_o, wid = __builtin_amdgcn_readfirstlane(tid >> 6), lane = tid & 63, wr = wid >> 2, wc = wid & 3, fr = lane & 15, fq = lane >> 4;
    const int K = g.K, nt = K / BK;
    unsigned voffA[2], voffB[2];
#pragma unroll
    for (int i = 0; i < 2; ++i) { int R, C; stage_rc(tid * 16 + i * 8192, R, C); const int Rb = Epi::PERM ? ((R & ~31) + perm32(R & 31)) : R;
        voffA[i] = (unsigned)(R * K + C) * 2u; voffB[i] = (unsigned)(Rb * K + C) * 2u; }
    const size_t kstep = (size_t)(BK * 2);
    const size_t hstep = (size_t)HALF * K * 2;
    const size_t tstep = 2 * hstep;
    const unsigned ldsw = (unsigned)wid * 1024u;
    const int aoff = lds_byte(wr * 64 + fr, fq * 8), boff = lds_byte(wc * 32 + fr, fq * 8);
#define PG8_SA(b, h) (((b) * 2 + (h)) * HTB)
#define PG8_SB(b, h) ((4 + (b) * 2 + (h)) * HTB)
#define PG8_STAGE(bufoff, gbase, voff) do { _Pragma("unroll") for (int _i = 0; _i < 2; ++_i) \
        __builtin_amdgcn_global_load_lds((const unsigned*)((const char*)(gbase) + (voff)[_i]), (PG8_LAS unsigned*)(lds + (bufoff) + ldsw + _i * 8192), 16, 0, 0); } while (0)
#define PG8_LDA(dst, b, h) do { _Pragma("unroll") for (int m = 0; m < 4; ++m) _Pragma("unroll") for (int k = 0; k < 2; ++k) dst[m][k] = *(const PG8_LAS bf16x8*)(lds + PG8_SA(b, h) + aoff + m * 2048 + k * 1024); } while (0)
#define PG8_LDB(dst, b, h) do { _Pragma("unroll") for (int n = 0; n < 2; ++n) _Pragma("unroll") for (int k = 0; k < 2; ++k) dst[n][k] = *(const PG8_LAS bf16x8*)(lds + PG8_SB(b, h) + boff + n * 2048 + k * 1024); } while (0)
#define PG8_MMA(ai, bj, At, Bt) do { __builtin_amdgcn_s_setprio(1); _Pragma("unroll") for (int m = 0; m < 4; ++m) _Pragma("unroll") for (int n = 0; n < 2; ++n) _Pragma("unroll") for (int k = 0; k < 2; ++k) \
        acc[ai][bj][m][n] = __builtin_amdgcn_mfma_f32_16x16x32_bf16(Bt[n][k], At[m][k], acc[ai][bj][m][n], 0, 0, 0); __builtin_amdgcn_s_setprio(0); } while (0)
#define PG8_WAIT_V(n) asm volatile("s_waitcnt vmcnt(" #n ")" ::: "memory")
#define PG8_WAIT_L(n) asm volatile("s_waitcnt lgkmcnt(" #n ")" ::: "memory")
#define PG8_BAR __builtin_amdgcn_s_barrier()
#define PG8_SCHED __builtin_amdgcn_sched_barrier(0)
    Unit cur, nxt; int ui = 0;
    if (!S.next(0, cur)) return;
    f32x4 acc[2][2][4][2];
#pragma unroll
    for (int a = 0; a < 2; ++a)
#pragma unroll
        for (int b = 0; b < 2; ++b)
#pragma unroll
            for (int m = 0; m < 4; ++m)
#pragma unroll
                for (int n = 0; n < 2; ++n) acc[a][b][m][n] = (f32x4){0.f, 0.f, 0.f, 0.f};
    bf16x8 At[4][2], B0[2][2], B1[2][2];
    const char* cA = (const char*)g.A + (size_t)cur.pm * tstep; const char* cB = (const char*)g.Bt + (size_t)cur.pn * tstep;
    S.a_ready(cur);
    if constexpr (SP2) {
        PG8_STAGE(PG8_SB(0, 0), cB, voffB); PG8_STAGE(PG8_SB(0, 1), cB + hstep, voffB); PG8_STAGE(PG8_SA(0, 0), cA, voffA); PG8_STAGE(PG8_SA(0, 1), cA + hstep, voffA);
        if (wr == 1) PG8_BAR;
        PG8_WAIT_V(2); PG8_BAR;
        PG8_STAGE(PG8_SB(1, 0), cB + kstep, voffB); PG8_STAGE(PG8_SA(1, 0), cA + kstep, voffA); PG8_STAGE(PG8_SB(1, 1), cB + hstep + kstep, voffB);
        PG8_WAIT_V(6); PG8_BAR;
    } else {
        PG8_STAGE(PG8_SB(0, 0), cB, voffB); PG8_STAGE(PG8_SA(0, 0), cA, voffA); PG8_STAGE(PG8_SB(0, 1), cB + hstep, voffB); PG8_STAGE(PG8_SA(0, 1), cA + hstep, voffA);
        if (wr == 1) PG8_BAR;
        PG8_WAIT_V(4); PG8_BAR;
        PG8_STAGE(PG8_SB(1, 0), cB + kstep, voffB); PG8_STAGE(PG8_SA(1, 0), cA + kstep, voffA); PG8_STAGE(PG8_SB(1, 1), cB + hstep + kstep, voffB);
        PG8_WAIT_V(6); PG8_BAR;
    }
    for (;;) {
        const bool has_next = S.next(ui + 1, nxt);
        const char* nA = has_next ? (const char*)g.A + (size_t)nxt.pm * tstep : cA; const char* nB = has_next ? (const char*)g.Bt + (size_t)nxt.pn * tstep : cB;
        for (int t = 0; t < nt; t += 2) {
            const bool last = (t == nt - 2);
            const char* a1 = cA + (size_t)(t + 1) * kstep;
            const char* a2 = last ? nA : cA + (size_t)(t + 2) * kstep; const char* b2 = last ? nB : cB + (size_t)(t + 2) * kstep;
            const char* a3 = a2 + kstep; const char* b3 = b2 + kstep;
            if (last && has_next) S.a_ready(nxt);
            if constexpr (SP2) {
            PG8_LDB(B0, 0, 0); PG8_LDB(B1, 0, 1); PG8_SCHED; PG8_LDA(At, 0, 0); PG8_STAGE(PG8_SA(1, 1), a1 + hstep, voffA);
            PG8_WAIT_V(8); PG8_WAIT_L(0); PG8_BAR; PG8_MMA(0, 0, At, B0); PG8_MMA(0, 1, At, B1); PG8_BAR; PG8_SCHED;
            PG8_LDA(At, 0, 1); PG8_STAGE(PG8_SB(0, 0), b2, voffB); PG8_STAGE(PG8_SB(0, 1), b2 + hstep, voffB); PG8_STAGE(PG8_SA(0, 0), a2, voffA);
            PG8_WAIT_V(8); PG8_WAIT_L(0); PG8_BAR; PG8_MMA(1, 0, At, B0); PG8_MMA(1, 1, At, B1); PG8_BAR; PG8_SCHED;
            PG8_LDB(B0, 1, 0); PG8_LDB(B1, 1, 1); PG8_SCHED; PG8_LDA(At, 1, 0); PG8_STAGE(PG8_SA(0, 1), a2 + hstep, voffA);
            PG8_WAIT_V(8); PG8_WAIT_L(0); PG8_BAR; PG8_MMA(0, 0, At, B0); PG8_MMA(0, 1, At, B1); PG8_BAR; PG8_SCHED;
            PG8_LDA(At, 1, 1); PG8_STAGE(PG8_SB(1, 0), b3, voffB); PG8_STAGE(PG8_SB(1, 1), b3 + hstep, voffB); PG8_STAGE(PG8_SA(1, 0), a3, voffA);
            PG8_WAIT_V(8); PG8_WAIT_L(0); PG8_BAR; PG8_MMA(1, 0, At, B0); PG8_MMA(1, 1, At, B1); PG8_BAR; PG8_SCHED;
            } else {
            PG8_LDB(B0, 0, 0); PG8_SCHED; PG8_LDA(At, 0, 0); PG8_STAGE(PG8_SA(1, 1), a1 + hstep, voffA);
            PG8_WAIT_L(8); PG8_BAR; PG8_WAIT_L(0); PG8_MMA(0, 0, At, B0); PG8_BAR; PG8_SCHED;
            PG8_LDB(B1, 0, 1); PG8_STAGE(PG8_SB(0, 0), b2, voffB);
            PG8_BAR; PG8_WAIT_L(0); PG8_MMA(0, 1, At, B1); PG8_BAR;
            PG8_LDA(At, 0, 1); PG8_STAGE(PG8_SA(0, 0), a2, voffA);
            PG8_BAR; PG8_WAIT_L(0); PG8_MMA(1, 0, At, B0); PG8_BAR; PG8_SCHED;
            PG8_STAGE(PG8_SB(0, 1), b2 + hstep, voffB);
            PG8_WAIT_V(6); PG8_BAR; PG8_MMA(1, 1, At, B1); PG8_BAR;
            PG8_LDB(B0, 1, 0); PG8_SCHED; PG8_LDA(At, 1, 0); PG8_STAGE(PG8_SA(0, 1), a2 + hstep, voffA);
            PG8_WAIT_L(8); PG8_BAR; PG8_WAIT_L(0); PG8_MMA(0, 0, At, B0); PG8_BAR; PG8_SCHED;
            PG8_LDB(B1, 1, 1); PG8_STAGE(PG8_SB(1, 0), b3, voffB);
            PG8_BAR; PG8_WAIT_L(0); PG8_MMA(0, 1, At, B1); PG8_BAR;
            PG8_LDA(At, 1, 1); PG8_STAGE(PG8_SA(1, 0), a3, voffA);
            PG8_BAR; PG8_WAIT_L(0); PG8_MMA(1, 0, At, B0); PG8_BAR; PG8_SCHED;
            PG8_STAGE(PG8_SB(1, 1), b3 + hstep, voffB);
            PG8_WAIT_V(6); PG8_BAR; PG8_MMA(1, 1, At, B1); PG8_BAR;
            }
        }
        if constexpr (ALIGN_EPI) { if (wr == 0) PG8_BAR; }
        if constexpr (!Epi::AFTER_DRAIN) { E(acc, cur, wr, wc, fr, fq); S.done(cur); }
        if (!has_next) break;
#pragma unroll
        for (int a = 0; a < 2; ++a)
#pragma unroll
            for (int b = 0; b < 2; ++b)
#pragma unroll
                for (int m = 0; m < 4; ++m)
#pragma unroll
                    for (int n = 0; n < 2; ++n) acc[a][b][m][n] = (f32x4){0.f, 0.f, 0.f, 0.f};
        cur = nxt; cA = nA; cB = nB; ++ui;
        if constexpr (ALIGN_EPI) { if (wr == 1) PG8_BAR; }
    }
    PG8_WAIT_V(0);
    if constexpr (!ALIGN_EPI) { if (wr == 0) PG8_BAR; }
    PG8_BAR;
    if constexpr (Epi::AFTER_DRAIN) { E.fused(acc, cur, wr, wc, fr, fq, lds, wid, lane); S.done(cur); }
#undef PG8_SA
#undef PG8_SB
#undef PG8_STAGE
#undef PG8_LDA
#undef PG8_LDB
#undef PG8_MMA
#undef PG8_WAIT_V
#undef PG8_WAIT_L
#undef PG8_BAR
#undef PG8_SCHED
}
}
namespace attn_body {
using bf16=__hip_bfloat16;
using bf16x8=__attribute__((ext_vector_type(8)))short;
using s16x4=__attribute__((ext_vector_type(4)))short;
using f32x16=__attribute__((ext_vector_type(16)))float;
using u32x4=__attribute__((ext_vector_type(4)))unsigned;
constexpr int D=64,PQ=1280,PO=1024;
constexpr int NW=8,QBLK=32,QB=QBLK*NW,KVBLK=64;
constexpr int ATTN_UNIT_ROWS=QB;
__device__ __forceinline__ int crow(int r,int hi){return (r&3)+8*(r>>2)+4*hi;}
#define SBAR() __builtin_amdgcn_sched_barrier(0)
__device__ __forceinline__ void wmask(f32x16&p0,f32x16&p1,int dl,int hi){
  const float NEG=-INFINITY; const int kb=4*hi;
  #pragma unroll
  for(int r=0;r<16;++r){int kv=kb+(r&3)+8*(r>>2); if((unsigned)(dl-kv+128)>256u)p0[r]=NEG; if((unsigned)(dl-kv-32+128)>256u)p1[r]=NEG;}
}

constexpr int NSLOT=3, SLOTB=8192;
constexpr int LDS_K=0, LDS_V=NSLOT*SLOTB, LDS_WS=2*NSLOT*SLOTB, LDS_OST=LDS_WS+NW*64*4, LDS_BYTES=LDS_OST+NW*4096;
constexpr float C2=0.125f*1.4426950408889634f;
__device__ __forceinline__ void glds16(const void*gsrc,unsigned lds_dst){unsigned keep;
  asm volatile("s_mov_b32 %0, m0\n\ts_mov_b32 m0, %2\n\ts_nop 0\n\tglobal_load_lds_dwordx4 %1, off\n\ts_mov_b32 m0, %0":"=&s"(keep):"v"(gsrc),"s"(lds_dst):"memory");}
__device__ __forceinline__ float max3f(float a,float b,float c){float r;asm("v_max3_f32 %0, %1, %2, %3":"=v"(r):"v"(a),"v"(b),"v"(c));return r;}
__device__ __forceinline__ float max2f(float a,float b){float r;asm("v_max_f32_e32 %0, %1, %2":"=v"(r):"v"(a),"v"(b));return r;}
__device__ __forceinline__ float fadd_s(float a,float b){float r;asm("v_add_f32_e32 %0, %1, %2":"=v"(r):"v"(a),"v"(b));return r;}
__device__ __forceinline__ float fsub_s(float a,float b){float r;asm("v_sub_f32_e32 %0, %1, %2":"=v"(r):"v"(a),"v"(b));return r;}
typedef float f32x2_t __attribute__((ext_vector_type(2))); typedef __bf16 bf16x2_t __attribute__((ext_vector_type(2)));
__device__ __forceinline__ unsigned cvtpk_s(float lo,float hi){f32x2_t v={lo,hi};bf16x2_t b=__builtin_convertvector(v,bf16x2_t);return __builtin_bit_cast(unsigned,b);}
#define WAIT_BAR(N) asm volatile("s_waitcnt vmcnt(" #N ") lgkmcnt(0)\n\ts_barrier":::"memory")

__device__ __forceinline__ void qkt(f32x16&p0,f32x16&p1,const char*Kslot,const bf16x8*qr,const f32x16&negm,int r32,int hi){
  const char*kb=Kslot+hi*1024+r32*16;
  #pragma unroll
  for(int d0=0;d0<4;++d0){
    const bf16x8 b0=*reinterpret_cast<const bf16x8*>(kb+d0*2048);
    const bf16x8 b1=*reinterpret_cast<const bf16x8*>(kb+d0*2048+512);
    if(d0==0){p0=__builtin_amdgcn_mfma_f32_32x32x16_bf16(b0,qr[0],negm,0,0,0);p1=__builtin_amdgcn_mfma_f32_32x32x16_bf16(b1,qr[0],negm,0,0,0);}
    else{p0=__builtin_amdgcn_mfma_f32_32x32x16_bf16(b0,qr[d0],p0,0,0,0);p1=__builtin_amdgcn_mfma_f32_32x32x16_bf16(b1,qr[d0],p1,0,0,0);}}
}
typedef __attribute__((address_space(3))) const char* lds_cptr;
typedef short v4i16_t __attribute__((ext_vector_type(4)));
__device__ __forceinline__ void kload8(bf16x8*kf,lds_cptr kp){
  kf[0]=*(const __attribute__((address_space(3))) bf16x8*)(kp);      kf[1]=*(const __attribute__((address_space(3))) bf16x8*)(kp+512);
  kf[2]=*(const __attribute__((address_space(3))) bf16x8*)(kp+2048); kf[3]=*(const __attribute__((address_space(3))) bf16x8*)(kp+2560);
  kf[4]=*(const __attribute__((address_space(3))) bf16x8*)(kp+4096); kf[5]=*(const __attribute__((address_space(3))) bf16x8*)(kp+4608);
  kf[6]=*(const __attribute__((address_space(3))) bf16x8*)(kp+6144); kf[7]=*(const __attribute__((address_space(3))) bf16x8*)(kp+6656);
}
__device__ __forceinline__ void kload2(bf16x8*kf,lds_cptr kp,int j){ kf[2*j]=*(const __attribute__((address_space(3))) bf16x8*)(kp+j*2048); kf[2*j+1]=*(const __attribute__((address_space(3))) bf16x8*)(kp+j*2048+512); }
__device__ __forceinline__ s16x4 vtr(lds_cptr p){ return __builtin_bit_cast(s16x4,__builtin_amdgcn_ds_read_tr16_b64_v4i16((__attribute__((address_space(3))) v4i16_t*)p)); }
__device__ __forceinline__ float rowmax(const f32x16&p0,const f32x16&p1){
  float a=max3f(p0[0],p0[1],p1[0]),b=max3f(p0[2],p0[3],p1[1]);a=max3f(a,p1[2],p1[3]);
  #pragma unroll
  for(int r=4;r<16;r+=4){a=max3f(a,p0[r],p0[r+1]);b=max3f(b,p0[r+2],p0[r+3]);a=max3f(a,p1[r],p1[r+1]);b=max3f(b,p1[r+2],p1[r+3]);}
  const float m=max2f(a,b);
  auto rr=__builtin_amdgcn_permlane32_swap(__float_as_uint(m),__float_as_uint(m),false,false);
  return max2f(__uint_as_float(rr[0]),__uint_as_float(rr[1]));
}
__device__ __forceinline__ void pv(f32x16*o,int vb,bf16x8 pa0,bf16x8 pa1,bf16x8 pa2,bf16x8 pa3){
  #pragma unroll
  for(int d0=0;d0<2;++d0){s16x4 lo[4],hi[4];
    #pragma unroll
    for(int ks=0;ks<4;++ks){
      asm volatile("ds_read_b64_tr_b16 %0,%1 offset:%c2":"=&v"(lo[ks]):"v"(vb),"i"(d0*4096+ks*1024):"memory");
      asm volatile("ds_read_b64_tr_b16 %0,%1 offset:%c2":"=&v"(hi[ks]):"v"(vb),"i"(d0*4096+ks*1024+512):"memory");}
    asm volatile("s_waitcnt lgkmcnt(0)":::"memory");SBAR();
    #define PK(k) (bf16x8){lo[k][0],lo[k][1],lo[k][2],lo[k][3],hi[k][0],hi[k][1],hi[k][2],hi[k][3]}
    o[d0]=__builtin_amdgcn_mfma_f32_32x32x16_bf16(pa0,PK(0),o[d0],0,0,0);
    o[d0]=__builtin_amdgcn_mfma_f32_32x32x16_bf16(pa1,PK(1),o[d0],0,0,0);
    o[d0]=__builtin_amdgcn_mfma_f32_32x32x16_bf16(pa2,PK(2),o[d0],0,0,0);
    o[d0]=__builtin_amdgcn_mfma_f32_32x32x16_bf16(pa3,PK(3),o[d0],0,0,0);
    #undef PK
  }
}

#ifndef ATTN_STORE16
#define ATTN_STORE16(p,v) (*(u32x4*)(p)=(v))
#endif
template<int THRL,bool WIN,bool FIXM> __device__ __forceinline__ void attn_unit(const bf16*Qu,const bf16*__restrict__ Kh,const bf16*__restrict__ Vh,bf16*Ou,const int NT,const int boff,const int dq,const float sink_l2,const float mfix,char*shm){
  int tid_o=threadIdx.x; asm volatile("":"+v"(tid_o));
  const int tid=tid_o,lane=tid&63,r32=lane&31,hi=lane>>5; const int wid=__builtin_amdgcn_readfirstlane(tid>>6);
  const bf16*Qw=Qu+(long)(wid*QBLK)*PQ;
  const unsigned lds0=(unsigned)(uintptr_t)shm;
  float*wsf=(float*)(shm+LDS_WS)+wid*64;
  const bf16*ksrc=Kh+(long)lane*PQ+wid*8;
  const bf16*vsrc=Vh+(long)(16*(wid&3)+(lane>>2))*PQ+(wid>>2)*32+(lane&3)*8;
  const unsigned kdst=lds0+LDS_K+wid*1024, vdst=lds0+LDS_V+wid*1024;
  #define TROW(t) ((long)(KVBLK*(t)+((WIN&&(t)>=4)?boff:0)))
  #define DMA_K(t,slot) glds16(ksrc+TROW(t)*PQ,(unsigned)__builtin_amdgcn_readfirstlane(kdst+(slot)))
  #define DMA_V(t,slot) glds16(vsrc+TROW(t)*PQ,(unsigned)__builtin_amdgcn_readfirstlane(vdst+(slot)))
  const int vb0=(int)(lds0+LDS_V)+((lane>>4)&1)*32+(lane&3)*8+(4*hi+((lane&15)>>2))*64;
  const char*Kbase=shm+LDS_K; bf16x8 kf[8];
  const lds_cptr shm3=(lds_cptr)shm; const lds_cptr kp0=shm3+LDS_K+hi*1024+r32*16; const lds_cptr vp0=shm3+LDS_V+((lane>>4)&1)*32+(lane&3)*8+(4*hi+((lane&15)>>2))*64;
  DMA_K(0,0);DMA_V(0,0);DMA_K(1,SLOTB);
  bf16x8 qr[4];
  #pragma unroll
  for(int d0=0;d0<4;++d0)qr[d0]=*reinterpret_cast<const bf16x8*>(&Qw[(long)r32*PQ+d0*16+hi*8]);
  float mhat=FIXM?mfix:0.f,l_reg=0.f;asm volatile("":"+v"(mhat));
  f32x16 o[2];{float z_=0.f;asm volatile("":"+v"(z_));
  _Pragma("unroll") for(int r=0;r<16;++r){o[0][r]=z_;o[1][r]=z_;}}f32x16 negm;
  #pragma unroll
  for(int r=0;r<16;++r)negm[r]=-mhat;
  asm volatile("":"+v"(negm));
  const int dqrel=dq+wid*QBLK+r32;
  #define CMASK(P0,P1,t) do{ if(WIN){ if((t)>=4){ const int wb_=dq+wid*QBLK-KVBLK*((t)-4);     \
      if(wb_>97||wb_<-65) wmask(P0,P1,dqrel-KVBLK*((t)-4),hi); } } }while(0)
  bool resc=false;
  #define START(P0,P1) do{ resc=false; \
    if(!FIXM){ const float rm=rowmax(P0,P1); const float dl=rm; mhat=fadd_s(mhat,dl); \
      _Pragma("unroll") for(int r=0;r<16;++r){P0[r]=fsub_s(P0[r],dl);P1[r]=fsub_s(P1[r],dl);} \
      _Pragma("unroll") for(int r=0;r<16;++r)negm[r]=-mhat; asm volatile("":"+v"(negm)); } \
    _Pragma("unroll") for(int r=0;r<16;++r)P0[r]=__builtin_amdgcn_exp2f(P0[r]); }while(0)
  #define RESC() do{ if(resc){ asm volatile("s_waitcnt lgkmcnt(0)":::"memory"); \
      _Pragma("unroll") for(int d_=0;d_<2;++d_) _Pragma("unroll") for(int r=0;r<16;++r)o[d_][r]*=wsf[crow(r,hi)]; } }while(0)
  f32x16 pA0,pA1,pB0,pB1;
  int sl_prev=0,sl_cur=0,sl_next=SLOTB;
  #define ROT() do{sl_prev=sl_cur;sl_cur=sl_next;sl_next=(sl_next==(NSLOT-1)*SLOTB)?0:sl_next+SLOTB;}while(0)
  DMA_K(2,2*SLOTB);
  WAIT_BAR(3);
  qkt(pA0,pA1,Kbase,qr,negm,r32,hi);asm volatile("s_nop 15\n\ts_nop 7":"+v"(pA0),"+v"(pA1));CMASK(pA0,pA1,0);
  START(pA0,pA1);
  _Pragma("unroll") for(int r=0;r<16;++r)pA1[r]=__builtin_amdgcn_exp2f(pA1[r]);
  WAIT_BAR(0);
  DMA_K(3,0);DMA_V(1,SLOTB);
  ROT();
  kload8(kf,kp0+sl_cur);
  WAIT_BAR(2);
  s16x4 vlo[8],vhi[8]; u32x4 pw0,pw1,pw2,pw3;
  #define PKW(P,B) cvtpk_s(P[B],P[B+1])
  #define PAF(k) __builtin_bit_cast(bf16x8,pw##k)
  #define VFR(i) (bf16x8){vlo[i][0],vlo[i][1],vlo[i][2],vlo[i][3],vhi[i][0],vhi[i][1],vhi[i][2],vhi[i][3]}
  #define PIN(x) asm volatile("":"+v"(x))
  #define MX3(a,b,c) __builtin_fmaxf(__builtin_fmaxf((a),(b)),(c))
  #define GAPA(MF,A0,A1,A2,A3,W0,W1,PW) do{ MF; sacc+=A0; sacc+=A1; sacc+=A2; sacc+=A3; PIN(sacc); W0; W1; PIN(PW); SBAR(); }while(0)
  #define EX(v) __builtin_amdgcn_exp2f(v)
  #define GAPB(MF,X,B) do{ MF; X[B]=EX(X[B]); X[B+1]=EX(X[B+1]); X[B+2]=EX(X[B+2]); X[B+3]=EX(X[B+3]); PIN(X); SBAR(); }while(0)
  #define VRD(i) do{ vlo[i]=vtr(vp_+(((i)>>2)*4096+((i)&3)*1024)); vhi[i]=vtr(vp_+(((i)>>2)*4096+((i)&3)*1024+512)); }while(0)
  #define KRD(G,j) do{ if(G){ kload2(kf,kp0+sl_next,j); SBAR(); } }while(0)
  #define STEP(C0,C1,P0,P1,t,GK,GV,GL) do{ SBAR(); \
    const lds_cptr vp_=vp0+sl_prev; \
    VRD(0); SBAR(); float sacc=(P0[0]+P0[1]); \
    GAPA(C0=__builtin_amdgcn_mfma_f32_32x32x16_bf16(kf[0],qr[0],negm,0,0,0), P0[2],P0[3],P0[4],P0[5],     pw0[0]=PKW(P0,0), pw0[1]=PKW(P0,2), pw0); \
    VRD(4); SBAR(); GAPA(C1=__builtin_amdgcn_mfma_f32_32x32x16_bf16(kf[1],qr[0],negm,0,0,0), P0[6],P0[7],P0[8],P0[9],     pw0[2]=PKW(P0,4), pw0[3]=PKW(P0,6), pw0); \
    VRD(1); SBAR(); GAPA(C0=__builtin_amdgcn_mfma_f32_32x32x16_bf16(kf[2],qr[1],C0,0,0,0),   P0[10],P0[11],P0[12],P0[13], pw1[0]=PKW(P0,8), pw1[1]=PKW(P0,10), pw1); \
    VRD(5); SBAR(); GAPA(C1=__builtin_amdgcn_mfma_f32_32x32x16_bf16(kf[3],qr[1],C1,0,0,0),   P0[14],P0[15],P1[0],P1[1],   pw1[2]=PKW(P0,12),pw1[3]=PKW(P0,14), pw1); \
    VRD(2); SBAR(); GAPA(C0=__builtin_amdgcn_mfma_f32_32x32x16_bf16(kf[4],qr[2],C0,0,0,0),   P1[2],P1[3],P1[4],P1[5],     pw2[0]=PKW(P1,0), pw2[1]=PKW(P1,2), pw2); \
    VRD(6); SBAR(); GAPA(C1=__builtin_amdgcn_mfma_f32_32x32x16_bf16(kf[5],qr[2],C1,0,0,0),   P1[6],P1[7],P1[8],P1[9],     pw2[2]=PKW(P1,4), pw2[3]=PKW(P1,6), pw2); \
    VRD(3); SBAR(); GAPA(C0=__builtin_amdgcn_mfma_f32_32x32x16_bf16(kf[6],qr[3],C0,0,0,0),   P1[10],P1[11],P1[12],P1[13], pw3[0]=PKW(P1,8), pw3[1]=PKW(P1,10), pw3); \
    VRD(7); SBAR(); GAPA(C1=__builtin_amdgcn_mfma_f32_32x32x16_bf16(kf[7],qr[3],C1,0,0,0),   P1[14],P1[15],0.f,0.f,       pw3[2]=PKW(P1,12),pw3[3]=PKW(P1,14), pw3); \
    l_reg+=sacc; \
    if(GK){DMA_K((t)+3,sl_cur);} if(GV){DMA_V((t)+1,sl_next);} \
    CMASK(C0,C1,t); \
    if(!FIXM){ float a=MX3(C0[0],C0[1],C1[0]),b=MX3(C0[2],C0[3],C1[1]); a=MX3(a,C1[2],C1[3]); \
      _Pragma("unroll") for(int r=4;r<16;r+=4){a=MX3(a,C0[r],C0[r+1]);b=MX3(b,C0[r+2],C0[r+3]);a=MX3(a,C1[r],C1[r+1]);b=MX3(b,C1[r+2],C1[r+3]);} \
      float rm=__builtin_fmaxf(a,b); { auto rr=__builtin_amdgcn_permlane32_swap(__float_as_uint(rm),__float_as_uint(rm),false,false); rm=__builtin_fmaxf(__uint_as_float(rr[0]),__uint_as_float(rr[1])); } \
      resc=false; \
      if(__builtin_expect(__any(rm>(float)THRL),0)){ const float dl=__builtin_fmaxf(rm,0.f); mhat+=dl; \
        _Pragma("unroll") for(int r=0;r<16;++r){C0[r]-=dl;C1[r]-=dl;} \
        _Pragma("unroll") for(int r=0;r<16;++r)negm[r]=-mhat; asm volatile("":"+v"(negm)); \
        const float f=__builtin_amdgcn_exp2f(-dl); l_reg*=f; if(hi==0)wsf[r32]=f; resc=true; } } \
    SBAR(); \
    GAPB(o[0]=__builtin_amdgcn_mfma_f32_32x32x16_bf16(PAF(0),VFR(0),o[0],0,0,0), C0,0); \
    GAPB(o[1]=__builtin_amdgcn_mfma_f32_32x32x16_bf16(PAF(0),VFR(4),o[1],0,0,0), C0,4); \
    KRD(GL,0); GAPB(o[0]=__builtin_amdgcn_mfma_f32_32x32x16_bf16(PAF(1),VFR(1),o[0],0,0,0), C0,8); \
    KRD(GL,1); GAPB(o[1]=__builtin_amdgcn_mfma_f32_32x32x16_bf16(PAF(1),VFR(5),o[1],0,0,0), C0,12); \
    KRD(GL,2); GAPB(o[0]=__builtin_amdgcn_mfma_f32_32x32x16_bf16(PAF(2),VFR(2),o[0],0,0,0), C1,0); \
    KRD(GL,3); GAPB(o[1]=__builtin_amdgcn_mfma_f32_32x32x16_bf16(PAF(2),VFR(6),o[1],0,0,0), C1,4); \
    GAPB(o[0]=__builtin_amdgcn_mfma_f32_32x32x16_bf16(PAF(3),VFR(3),o[0],0,0,0), C1,8); \
    GAPB(o[1]=__builtin_amdgcn_mfma_f32_32x32x16_bf16(PAF(3),VFR(7),o[1],0,0,0), C1,12); \
    }while(0)
  int t=1;
  for(;t+5<NT;t+=2){
    STEP(pB0,pB1,pA0,pA1,t,true,true,true);     WAIT_BAR(2); RESC(); ROT();
    STEP(pA0,pA1,pB0,pB1,t+1,true,true,true);   WAIT_BAR(2); RESC(); ROT();
  }
  #define ENDW(tt) do{ if((tt)+3<NT){WAIT_BAR(2);} else if((tt)+2<NT){WAIT_BAR(1);} else {WAIT_BAR(0);} }while(0)
  for(;t+1<NT;t+=2){
    STEP(pB0,pB1,pA0,pA1,t,(t+3<NT),(t+1<NT),(t+1<NT));       ENDW(t);   RESC(); ROT();
    STEP(pA0,pA1,pB0,pB1,t+1,(t+4<NT),(t+2<NT),(t+2<NT));     ENDW(t+1); RESC(); ROT();
  }
  STEP(pB0,pB1,pA0,pA1,NT-1,false,false,false); RESC();
  { float sacc=pB0[0]+pB0[1]; _Pragma("unroll") for(int r=2;r<16;++r)sacc+=pB0[r]; _Pragma("unroll") for(int r=0;r<16;++r)sacc+=pB1[r]; l_reg+=sacc;
    pw0=(u32x4){PKW(pB0,0),PKW(pB0,2),PKW(pB0,4),PKW(pB0,6)};pw1=(u32x4){PKW(pB0,8),PKW(pB0,10),PKW(pB0,12),PKW(pB0,14)};pw2=(u32x4){PKW(pB1,0),PKW(pB1,2),PKW(pB1,4),PKW(pB1,6)};pw3=(u32x4){PKW(pB1,8),PKW(pB1,10),PKW(pB1,12),PKW(pB1,14)};
    SBAR(); pv(o,vb0+sl_cur,PAF(0),PAF(1),PAF(2),PAF(3)); }
  #undef PKW
  #undef PAF
  #undef VFR
  #undef PIN
  #undef MX3
  #undef GAPA
  #undef GAPB
  #undef EX
  #undef VRD
  #undef KRD
  #undef STEP
  #undef ENDW
  {auto rr=__builtin_amdgcn_permlane32_swap(__float_as_uint(l_reg),__float_as_uint(l_reg),false,false);l_reg=__uint_as_float(rr[0])+__uint_as_float(rr[1]);}
  l_reg+=__builtin_amdgcn_exp2f(sink_l2-mhat);
  if(hi==0)wsf[32+r32]=l_reg;asm volatile("s_waitcnt lgkmcnt(0)":::"memory");
  float rli[16];
  #pragma unroll
  for(int r=0;r<16;++r)rli[r]=__builtin_amdgcn_rcpf(wsf[32+crow(r,hi)]);
  bf16*Ow=Ou+(long)(wid*QBLK)*PO;
  { bf16*stg=(bf16*)(shm+LDS_OST)+wid*2048;
    #pragma unroll
    for(int r=0;r<16;++r){const int orow=crow(r,hi);
      #pragma unroll
      for(int d0=0;d0<2;++d0)stg[orow*64+d0*32+r32]=__float2bfloat16(o[d0][r]*rli[r]);}
    asm volatile("s_waitcnt lgkmcnt(0)":::"memory");
    #pragma unroll
    for(int i=0;i<4;++i){const int row=i*8+(lane>>3),ch=lane&7; const u32x4 v=*(const u32x4*)(stg+row*64+ch*8); ATTN_STORE16(Ow+(long)row*PO+ch*8,v);} }
  asm volatile("s_waitcnt lgkmcnt(0)\n\ts_barrier":::"memory");
  #undef TROW
  #undef DMA_K
  #undef DMA_V
  #undef CMASK
  #undef START
  #undef RESC
  #undef ROT
}
constexpr int ATTN_LDS_BYTES=LDS_BYTES;
#undef SBAR
#undef WAIT_BAR
}
namespace cg = cooperative_groups;
#define LAS __attribute__((address_space(3)))
typedef unsigned short u16;
typedef unsigned v4u __attribute__((ext_vector_type(4)));
typedef float f32x4 __attribute__((ext_vector_type(4)));
#define LDS_WAIT() asm volatile("s_waitcnt lgkmcnt(0)" ::: "memory")
#define XB_TMO      128
#define XB_XCNT(j)  (256  + 64 * (j))
#define XB_XSUB(j)  (1280 + 64 * (j))
#define XB_XGEN(j)  (2304 + 64 * (j))
#define XB_TOP      3328
#define XB_TOPGEN   3392
#define XCD_BAR_WORDS 3456
#define XB_SPIN_CAP (1u << 18)

__device__ __forceinline__ unsigned xb_ld(unsigned* p)              { return __hip_atomic_load(p, __ATOMIC_RELAXED, __HIP_MEMORY_SCOPE_AGENT); }
__device__ __forceinline__ unsigned xb_add(unsigned* p, unsigned v) { return __hip_atomic_fetch_add(p, v, __ATOMIC_RELAXED, __HIP_MEMORY_SCOPE_AGENT); }
__device__ __forceinline__ unsigned xb_xcc_id() { return (unsigned)__builtin_amdgcn_s_getreg((3 << 11) | 20) & 0xFu; }
#define XB_SPIN(cond, bar) do { unsigned _sp = 0; while (cond) { __builtin_amdgcn_s_sleep(1); \
    if ((++_sp & 255u) == 0u) { if (xb_ld(&(bar)[XB_TMO])) break; if (_sp > XB_SPIN_CAP) { atomicAdd(&(bar)[XB_TMO], 1u); break; } } } } while (0)

struct XcdBarrier {
    unsigned* bar; unsigned x;
    volatile LAS unsigned* st;
};

__device__ __forceinline__ XcdBarrier xcd_barrier_post(unsigned* bar, volatile LAS unsigned* st) {
    XcdBarrier b; b.bar = bar; b.x = xb_xcc_id(); b.st = st;
    if (threadIdx.x == 0) (void)xb_add(&bar[XB_XCNT(b.x)], 1u);
    return b;
}
__device__ __forceinline__ void xcd_barrier_complete(unsigned* bar, unsigned x, unsigned& nloc, unsigned& nx) {
    const unsigned G = gridDim.x * gridDim.y * gridDim.z;
    unsigned sum, cnt, mine, sp = 0u;
    for (;;) {
        sum = 0u; cnt = 0u; mine = 0u;
#pragma unroll
        for (unsigned j = 0; j < 16; ++j) { const unsigned c = xb_ld(&bar[XB_XCNT(j)]); sum += c; cnt += (c > 0u) ? 1u : 0u; mine = (j == x) ? c : mine; }
        if (sum == G) break;
        __builtin_amdgcn_s_sleep(1);
        if ((++sp & 255u) == 0u) { if (xb_ld(&bar[XB_TMO])) break; if (sp > XB_SPIN_CAP) { atomicAdd(&bar[XB_TMO], 1u); break; } }
    }
    nloc = mine > 0u ? mine : 1u; nx = cnt > 0u ? cnt : 1u;
}

__device__ __forceinline__ void xcd_barrier(const XcdBarrier& b) {
    asm volatile("s_waitcnt vmcnt(0)" ::: "memory");
    __syncthreads();
    if (threadIdx.x == 0) {
        unsigned* bar = b.bar;
        __builtin_amdgcn_s_waitcnt(0);
        unsigned nloc = b.st[0], nx = b.st[1];
        if (nloc == 0u) { xcd_barrier_complete(bar, b.x, nloc, nx); b.st[0] = nloc; b.st[1] = nx; }
        const unsigned old = xb_add(&bar[XB_XSUB(b.x)], 1u);
        const unsigned gen = old / nloc;
        if (old + 1u == (gen + 1u) * nloc) {
            __builtin_amdgcn_fence(__ATOMIC_RELEASE, "agent");
            asm volatile("s_waitcnt vmcnt(0)" ::: "memory");
            const unsigned og = xb_add(&bar[XB_TOP], 1u);
            const unsigned tg = og / nx;
            if (og + 1u == (tg + 1u) * nx) xb_add(&bar[XB_TOPGEN], 1u);
            else XB_SPIN(xb_ld(&bar[XB_TOPGEN]) == tg, bar);
            __builtin_amdgcn_fence(__ATOMIC_ACQUIRE, "agent");
            xb_add(&bar[XB_XGEN(b.x)], 1u);
            asm volatile("s_waitcnt vmcnt(0)" ::: "memory");
        } else {
            XB_SPIN(xb_ld(&bar[XB_XGEN(b.x)]) == gen, bar);
            __builtin_amdgcn_fence(__ATOMIC_ACQUIRE, "agent");
            asm volatile("s_waitcnt vmcnt(0)" ::: "memory");
        }
    }
    __syncthreads();
}


constexpr int NWAVES = 8, NTHREADS = NWAVES * 64;
constexpr int DM = 1024, NB = 8, SEQ = 8192, CTX = 256, BR = SEQ + CTX, MROWS = NB * BR, NIN = 1536, PQW = 1280, FF = 2816, NGU = 2 * FF;
constexpr size_t MiB = 1u << 20;
constexpr size_t WS_PART = 1 * MiB;
constexpr size_t WS_MOD = 8 * MiB;
constexpr size_t WS_TC = 9 * MiB;
constexpr size_t WS_ROPE = 10 * MiB;
constexpr size_t WS_W = 12 * MiB, W_LAYER = 22 * MiB, W_IN = 0, W_OUT = 3 * MiB + 512 * 1024, W_GU = W_OUT + 2 * MiB, W_DN = W_GU + 11 * MiB;
constexpr size_t WS_G = 56 * MiB;
constexpr size_t WS_P = WS_G, WS_O = WS_P + 165 * MiB, WS_UT = WS_O + 132 * MiB, WS_UTC = WS_UT + 64 * MiB;
constexpr size_t WS_H = WS_G + 363 * MiB;
constexpr size_t WS_X = WS_H + 132 * MiB;
constexpr size_t WS_UF = WS_X + 264 * MiB;
constexpr size_t WS_END = WS_UF + 64 * MiB;
static_assert(WS_W + 2 * W_LAYER <= WS_G && WS_UTC + 2 * MiB <= WS_H && W_DN + 5 * MiB + 512 * 1024 <= W_LAYER, "d_ws map");
constexpr int RING_BYTES = 131072, LDS_BYTES = 147456;

struct Args { const float* in[17]; float* out; unsigned char* ws; };

__device__ __forceinline__ float wave_sum(float v) {
    v = pg8::lane_xor_add<1>(v); v = pg8::lane_xor_add<2>(v); v = pg8::lane_xor_add<4>(v); v = pg8::lane_xor_add<8>(v); v = pg8::lane_xor_add<16>(v); v = pg8::lane_xor_add<32>(v);
    return v;
}
__device__ __forceinline__ unsigned pk2(float lo, float hi) { return pg8::cvt_pk_bf16(lo, hi); }

__device__ __forceinline__ void tr_item(const float* W, int K, int N, u16* WT, int k0, int n0, int drow0, LAS float* scr, int lane) {
#pragma unroll 8
    for (int i = 0; i < 32; ++i) { const int kk = 2 * i + (lane >> 5); scr[kk * 33 + (lane & 31)] = W[(size_t)(k0 + kk) * N + n0 + (lane & 31)]; }
    LDS_WAIT(); asm volatile("" ::: "memory");
    const int c = lane & 7;
#pragma unroll
    for (int j = 0; j < 4; ++j) { const int n = (lane >> 3) + 8 * j; const LAS float* s = scr + (8 * c) * 33 + n;
        v4u o; o.x = pk2(s[0 * 33], s[1 * 33]); o.y = pk2(s[2 * 33], s[3 * 33]); o.z = pk2(s[4 * 33], s[5 * 33]); o.w = pk2(s[6 * 33], s[7 * 33]);
        *(v4u*)(WT + (size_t)(drow0 + n) * K + k0 + 8 * c) = o; }
    LDS_WAIT(); asm volatile("" ::: "memory");
}
__device__ __forceinline__ void fmix_item(const float* Win, u16* WinT, int item, LAS float* scr, int lane) {
    const int g = item & 3, k0 = (item >> 2) * 32;
    LAS float* tabc = scr + 32 * 65; LAS float* tabs = tabc + 64;
    tabc[lane] = __builtin_amdgcn_cosf((float)lane * (1.0f / 64.0f)); tabs[lane] = __builtin_amdgcn_sinf((float)lane * (1.0f / 64.0f));
#pragma unroll 8
    for (int i = 0; i < 32; ++i) scr[i * 65 + lane] = Win[(size_t)(k0 + i) * 1536 + 640 + g * 64 + lane];
    LDS_WAIT(); asm volatile("" ::: "memory");
    const int fqn = lane <= 32 ? lane : lane - 32; const LAS float* tab = lane <= 32 ? tabc : tabs;
    float ac[32];
#pragma unroll
    for (int kk = 0; kk < 32; ++kk) ac[kk] = 0.f;
#pragma unroll 2
    for (int c = 0; c < 64; ++c) { const float tv = tab[(c * fqn) & 63];
#pragma unroll
        for (int kk = 0; kk < 32; ++kk) ac[kk] += scr[kk * 65 + c] * tv; }
    const int drow = 128 * (lane >> 5) + 32 * g + (lane & 31);
    u16* dc = WinT + (size_t)(1280 + drow) * 1024 + k0;
#pragma unroll
    for (int q = 0; q < 4; ++q) {
        v4u o; o.x = pk2(ac[8 * q], ac[8 * q + 1]); o.y = pk2(ac[8 * q + 2], ac[8 * q + 3]); o.z = pk2(ac[8 * q + 4], ac[8 * q + 5]); o.w = pk2(ac[8 * q + 6], ac[8 * q + 7]);
        *(v4u*)(dc + 8 * q) = o; }
    LDS_WAIT(); asm volatile("" ::: "memory");
}
__device__ __forceinline__ void ada_item(const float* c, const float* c_ctx, const float* w_ada, float* part, int item, LAS float* scr, int lane) {
    const int cb = item % 96, s = (item / 96) & 15, l = item / (96 * 16);
#pragma unroll
    for (int r = 0; r < 9; ++r) { const float v = (r < 8) ? c[r * 1024 + s * 64 + lane] : c_ctx[s * 64 + lane]; scr[r * 64 + lane] = v / (1.0f + __expf(-v)); }
    LDS_WAIT(); asm volatile("" ::: "memory");
    float acc[9];
#pragma unroll
    for (int r = 0; r < 9; ++r) acc[r] = 0.f;
    const float* wp = w_ada + (size_t)l * 1024 * 6144 + (size_t)(s * 64) * 6144 + cb * 64 + lane;
#pragma unroll 8
    for (int kk = 0; kk < 64; ++kk) { const float w = wp[(size_t)kk * 6144];
#pragma unroll
        for (int r = 0; r < 9; ++r) acc[r] += scr[r * 64 + kk] * w; }
#pragma unroll
    for (int r = 0; r < 9; ++r) part[((size_t)(s * 2 + l) * 9 + r) * 6144 + cb * 64 + lane] = acc[r];
    LDS_WAIT(); asm volatile("" ::: "memory");
}

__device__ __forceinline__ void norm_row_bf16(const float* xrow, const float* A, const float* B, u16* orow, int lane) {
    const f32x4* xr = (const f32x4*)xrow + lane; const f32x4* ar = (const f32x4*)A + lane; const f32x4* br = (const f32x4*)B + lane;
    f32x4 v[4]; float s = 0.f;
#pragma unroll
    for (int j = 0; j < 4; ++j) { v[j] = xr[64 * j]; s += (v[j].x * v[j].x + v[j].y * v[j].y) + (v[j].z * v[j].z + v[j].w * v[j].w); }
    const float rstd = 1.0f / sqrtf(wave_sum(s) * (1.0f / 1024.0f) + 1e-6f);
    unsigned long long* o8 = (unsigned long long*)orow + lane;
#pragma unroll
    for (int j = 0; j < 4; ++j) { const f32x4 y = v[j] * rstd * ar[64 * j] + br[64 * j];
        o8[64 * j] = (unsigned long long)pk2(y.x, y.y) | ((unsigned long long)pk2(y.z, y.w) << 32); }
}

__device__ __forceinline__ void conv_weights(const float* w_in_, const float* w_out_, const float* w_gate_, const float* w_up_, const float* w_down_, u16* wbase, int l, int gwx, int ngwx, LAS float* scr, int lane) {
    constexpr int I_IN = 16 * 40, I_OUT = 16 * 32, I_GT = 16 * 88, I_DN = 44 * 32, I_LAYER = I_IN + I_OUT + 2 * I_GT + I_DN;
    u16* wl = wbase + (size_t)l * (W_LAYER / 2);
    for (int it = gwx; it < I_LAYER; it += ngwx) { int r = it;
        if (r < I_IN) { const int kb = r / 40, nb0 = r % 40, nb = nb0 < 20 ? nb0 : nb0 + 8;
            const int n0 = nb * 32, slot = n0 < 640 ? n0 / 64 : (n0 - 896) / 64 + 10, bj = (n0 & 63) >> 5;
            tr_item(w_in_ + (size_t)l * 1024 * 1536, 1024, 1536, wl + W_IN / 2, kb * 64, n0, 256 * (slot >> 2) + 128 * bj + 32 * (slot & 3), scr, lane); continue; }
        r -= I_IN;
        if (r < I_OUT) { const int kb = r / 32, nb = r % 32; tr_item(w_out_ + (size_t)l * 1024 * 1024, 1024, 1024, wl + W_OUT / 2, kb * 64, nb * 32, nb * 32, scr, lane); continue; }
        r -= I_OUT;
        if (r < 2 * I_GT) { const int up = r / I_GT; r %= I_GT; const int kb = r / 88, nb = r % 88, n0 = nb * 32;
            tr_item((up ? w_up_ : w_gate_) + (size_t)l * 1024 * FF, 1024, FF, wl + W_GU / 2, kb * 64, n0, 256 * (n0 >> 7) + 128 * up + (n0 & 127), scr, lane); continue; }
        r -= 2 * I_GT;
        { const int kb = r / 32, nb = r % 32; tr_item(w_down_ + (size_t)l * FF * 1024, FF, 1024, wl + W_DN / 2, kb * 64, nb * 32, nb * 32, scr, lane); }
    }
    for (int it = gwx; it < 128; it += ngwx) fmix_item(w_in_ + (size_t)l * 1024 * 1536, wl + W_IN / 2, it, scr, lane);
}

__device__ constexpr float FFT_C32[16] = {1.000000000f, 0.980785280f, 0.923879533f, 0.831469612f, 0.707106781f, 0.555570233f, 0.382683432f, 0.195090322f, 0.000000000f, -0.195090322f, -0.382683432f, -0.555570233f, -0.707106781f, -0.831469612f, -0.923879533f, -0.980785280f};
__device__ constexpr float FFT_S32[16] = {0.000000000f, 0.195090322f, 0.382683432f, 0.555570233f, 0.707106781f, 0.831469612f, 0.923879533f, 0.980785280f, 1.000000000f, 0.980785280f, 0.923879533f, 0.831469612f, 0.707106781f, 0.555570233f, 0.382683432f, 0.195090322f};
template <int HALF> __device__ __forceinline__ void fft32_stage(float (&xr)[32], float (&xi)[32]) {
#pragma unroll
    for (int blk = 0; blk < 32; blk += 2 * HALF)
#pragma unroll
        for (int j = 0; j < HALF; ++j) { const int i0 = blk + j, i1 = i0 + HALF, m = j * (16 / HALF);
            const float tr = xr[i0] - xr[i1], ti = xi[i0] - xi[i1]; xr[i0] += xr[i1]; xi[i0] += xi[i1];
            if (m == 0) { xr[i1] = tr; xi[i1] = ti; }
            else if (m == 8) { xr[i1] = ti; xi[i1] = -tr; }
            else { const float c = FFT_C32[m], s = FFT_S32[m]; xr[i1] = tr * c + ti * s; xi[i1] = ti * c - tr * s; } }
}
__device__ __forceinline__ constexpr int bitrev5(int k) { return ((k & 1) << 4) | ((k & 2) << 2) | (k & 4) | ((k & 8) >> 2) | ((k & 16) >> 4); }
__device__ __forceinline__ void fft32_item(const u16* ra, const u16* rb, bool hasb, float nsg, u16* Zb, int b, int n, int l2) {
    unsigned wre[32], wim[32], ox[32], oy[32];
#pragma unroll
    for (int j = 0; j < 32; ++j) { wre[j] = *(const unsigned*)(ra + 256 * j + l2); wim[j] = hasb ? *(const unsigned*)(rb + 256 * j + l2) : 0u; }
#pragma unroll
    for (int h = 0; h < 2; ++h) {
        float xr[32], xi[32];
#pragma unroll
        for (int j = 0; j < 32; ++j) { xr[j] = __uint_as_float(h ? (wre[j] & 0xffff0000u) : (wre[j] << 16)); xi[j] = nsg * __uint_as_float(h ? (wim[j] & 0xffff0000u) : (wim[j] << 16)); }
        fft32_stage<16>(xr, xi); fft32_stage<8>(xr, xi); fft32_stage<4>(xr, xi); fft32_stage<2>(xr, xi); fft32_stage<1>(xr, xi);
#pragma unroll
        for (int k1 = 0; k1 < 32; ++k1) { const float yx = xr[bitrev5(k1)], yy = xi[bitrev5(k1)];
            const float rev = (float)((k1 * (l2 + h)) & 8191) * (1.0f / 8192.0f); const float ca = __builtin_amdgcn_cosf(rev), sa = __builtin_amdgcn_sinf(rev);
            const float zx = yx * ca + yy * sa, zy = yy * ca - yx * sa;
            if (h == 0) { ox[k1] = pk2(zx, 0.f); oy[k1] = pk2(-zy, 0.f); } else { ox[k1] |= pk2(0.f, zx); oy[k1] |= pk2(0.f, -zy); } }
    }
#pragma unroll
    for (int k1 = 0; k1 < 32; ++k1) { u16* zp = Zb + ((size_t)((b * 32 + k1) * 256 + n)) * 512 + l2; *(unsigned*)zp = ox[k1]; *(unsigned*)(zp + 256) = oy[k1]; }
}

template <bool FINAL, bool SRC16> __device__ __forceinline__ void norm4_rows(const void* x0v, const float* A, const float* B, void* o0, int lane) {
    f32x4 v[4][4]; float s[4];
#pragma unroll
    for (int r = 0; r < 4; ++r)
#pragma unroll
        for (int j = 0; j < 4; ++j) {
            if (SRC16) { typedef unsigned u32x2 __attribute__((ext_vector_type(2))); const u32x2 w = ((const u32x2*)((const u16*)x0v + (size_t)r * 1024))[lane + 64 * j];
                v[r][j] = (f32x4){__uint_as_float(w.x << 16), __uint_as_float(w.x & 0xffff0000u), __uint_as_float(w.y << 16), __uint_as_float(w.y & 0xffff0000u)}; }
            else v[r][j] = ((const f32x4*)((const float*)x0v + (size_t)r * 1024))[lane + 64 * j]; }
#pragma unroll
    for (int r = 0; r < 4; ++r) { s[r] = 0.f;
#pragma unroll
        for (int j = 0; j < 4; ++j) s[r] += (v[r][j].x * v[r][j].x + v[r][j].y * v[r][j].y) + (v[r][j].z * v[r][j].z + v[r][j].w * v[r][j].w); }
#pragma unroll
    for (int r = 0; r < 4; ++r) { s[r] = pg8::lane_xor_add<1>(s[r]); s[r] = pg8::lane_xor_add<2>(s[r]); s[r] = pg8::lane_xor_add<4>(s[r]); s[r] = pg8::lane_xor_add<8>(s[r]); s[r] = pg8::lane_xor_add<16>(s[r]); s[r] = pg8::lane_xor_add<32>(s[r]); }
    f32x4 a[4], b[4];
#pragma unroll
    for (int j = 0; j < 4; ++j) { a[j] = ((const f32x4*)A)[lane + 64 * j]; b[j] = FINAL ? (f32x4){0.f, 0.f, 0.f, 0.f} : ((const f32x4*)B)[lane + 64 * j]; }
#pragma unroll
    for (int r = 0; r < 4; ++r) { const float rstd = 1.0f / sqrtf(s[r] * (1.0f / 1024.0f) + 1e-6f);
#pragma unroll
        for (int j = 0; j < 4; ++j) { const f32x4 y = v[r][j] * rstd * a[j] + b[j];
            if (FINAL) ((f32x4*)((float*)o0 + (size_t)r * 1024))[lane + 64 * j] = y;
            else ((unsigned long long*)((u16*)o0 + (size_t)r * 1024))[lane + 64 * j] = (unsigned long long)pk2(y.x, y.y) | ((unsigned long long)pk2(y.z, y.w) << 32); } }
}

__global__ void __launch_bounds__(NTHREADS, 2) hybrid_fwd(Args args) {
    extern __shared__ __attribute__((aligned(16))) unsigned char lds[];
    cg::grid_group grid = cg::this_grid();
    LAS unsigned char* ldsA = (LAS unsigned char*)lds;
#define PH_BASE() size_t wz_ = 0; asm volatile("" : "+s"(wz_)); unsigned char* ws = args.ws + wz_; int G = gridDim.x; asm volatile("" : "+s"(G)); int bx = blockIdx.x; asm volatile("" : "+s"(bx)); \
    const int vcu = (G % 8 == 0) ? (bx % 8) * (G / 8) + bx / 8 : bx; const int NGW = G * NWAVES, NGT = NGW * 64; (void)vcu; (void)NGT; (void)NGW
#define PH_IDS() int tid_o = threadIdx.x; asm volatile("" : "+v"(tid_o)); const int lane = tid_o & 63, wave = __builtin_amdgcn_readfirstlane(tid_o >> 6), gw = vcu * NWAVES + wave, gtid = gw * 64 + lane; (void)gtid; (void)gw
#define x_in (args.in[0])
#define c_in (args.in[1])
#define ctx_in (args.in[2])
#define cctx_in (args.in[3])
#define w_ada (args.in[4])
#define b_ada (args.in[5])
#define g_mix (args.in[6])
#define g_ffn (args.in[7])
#define w_in (args.in[8])
#define q_norm (args.in[9])
#define k_norm (args.in[10])
#define sink (args.in[11])
#define w_out (args.in[12])
#define w_gate (args.in[13])
#define w_up (args.in[14])
#define w_down (args.in[15])
#define g_final (args.in[16])
#define PART ((float*)(ws + WS_PART))
#define MOD ((float*)(ws + WS_MOD))
#define TC ((u16*)(ws + WS_TC))
#define ROPE ((float*)(ws + WS_ROPE))
#define Pb ((u16*)(ws + WS_P))
#define Ob ((u16*)(ws + WS_O))
#define UT ((u16*)(ws + WS_UT))
#define UTC ((u16*)(ws + WS_UTC))
#define UTCC ((u16*)(ws + WS_ROPE))
#define Gb ((u16*)(ws + WS_G))
#define Hb ((u16*)(ws + WS_H))
#define X ((u16*)(ws + WS_X))
#define UF ((u16*)(ws + WS_UF))
#define FLAGS ((unsigned*)ws)
#define WL ((const u16*)(ws + WS_W + (size_t)l * W_LAYER))
#define MODL (MOD + (size_t)l * 9 * 6 * 1024)
#define GRID_BAR() do { XcdBarrier b_; b_.bar = (unsigned*)args.ws + 1024; b_.x = xb_xcc_id(); b_.st = (volatile LAS unsigned*)(ldsA + RING_BYTES + 64); xcd_barrier(b_); } while (0)

    {
        PH_BASE(); PH_IDS();
        LAS float* scr = (LAS float*)(ldsA + wave * 16384);
        if (bx == 0) { if (tid_o < 2) __hip_atomic_store(FLAGS + 64 * tid_o, 0u, __ATOMIC_RELAXED, __HIP_MEMORY_SCOPE_AGENT);
            for (int w = tid_o; w < XCD_BAR_WORDS; w += NTHREADS) __hip_atomic_store(FLAGS + 1024 + w, 0u, __ATOMIC_RELAXED, __HIP_MEMORY_SCOPE_AGENT); }
        if (tid_o < 2) ((volatile LAS unsigned*)(ldsA + RING_BYTES + 64))[tid_o] = 0u;
        for (int it = gw; it < 2 * 16 * 96; it += NGW) ada_item(c_in, cctx_in, w_ada, PART, it, scr, lane);
        for (int idx = gtid; idx < 256 * 64; idx += NGT) { const int k = idx >> 6, kk0 = (idx & 63) << 3; const bool sn = kk0 >= 256; const int l0 = kk0 & 255;
            float v[8];
#pragma unroll
            for (int j = 0; j < 8; ++j) { const float rev = (float)((k * (l0 + j)) & 255) * (1.0f / 256.0f); v[j] = sn ? -__builtin_amdgcn_sinf(rev) : __builtin_amdgcn_cosf(rev); }
            v4u o; o.x = pk2(v[0], v[1]); o.y = pk2(v[2], v[3]); o.z = pk2(v[4], v[5]); o.w = pk2(v[6], v[7]);
            *(v4u*)(TC + (size_t)idx * 8) = o; }
    }
    grid.sync();
    (void)xcd_barrier_post((unsigned*)args.ws + 1024, (volatile LAS unsigned*)(ldsA + RING_BYTES + 64));
    { PH_BASE(); PH_IDS();
    for (int idx = gtid; idx < 2 * 9 * 1024; idx += NGT) { const int col = idx & 1023, r = (idx >> 10) % 9, l = idx / 9216;
        float m[6];
#pragma unroll
        for (int w = 0; w < 6; ++w) { float a = b_ada[l * 6144 + w * 1024 + col];
            for (int s = 0; s < 16; ++s) a += PART[((size_t)(s * 2 + l) * 9 + r) * 6144 + w * 1024 + col];
            m[w] = a; }
        float* o = MOD + (size_t)((l * 9 + r) * 6) * 1024 + col;
        o[0] = g_mix[l * 1024 + col] * (1.0f + m[1]); o[1024] = m[0]; o[2048] = m[2];
        o[3072] = g_ffn[l * 1024 + col] * (1.0f + m[4]); o[4096] = m[3]; o[5120] = m[5]; }
    }
    GRID_BAR();

#pragma nounroll
    for (int l = 0; l < 2; ++l) {
        { PH_BASE(); PH_IDS();
        if (l == 0) {
            LAS float* scr = (LAS float*)(ldsA + wave * 16384);
            conv_weights(w_in, w_out, w_gate, w_up, w_down, (u16*)(ws + WS_W), 0, gw, NGW, scr, lane);
            for (int row = 4 * gw; row < MROWS; row += 4 * NGW) { const int b = row / BR, p = row % BR; const bool is_ctx = p < CTX; const int r = is_ctx ? 8 : b;
                norm4_rows<false, false>(is_ctx ? ctx_in + (size_t)(b * CTX + p) * DM : x_in + (size_t)(b * SEQ + p - CTX) * DM, MODL + (size_t)(r * 6 + 0) * 1024, MODL + (size_t)(r * 6 + 1) * 1024, Hb + (size_t)row * DM, lane); }
        } else {
            for (int q = gw; q < NB * CTX / 4; q += NGW) { const int row = (q >> 6) * BR + (q & 63) * 4;
                norm4_rows<false, true>(X + (size_t)row * DM, MODL + (size_t)(8 * 6 + 0) * 1024, MODL + (size_t)(8 * 6 + 1) * 1024, Hb + (size_t)row * DM, lane); }
        } }
        GRID_BAR();
#pragma nounroll
        for (int sp = 0; sp < 2; ++sp) {
            PH_BASE();
            if (sp == 1 && bx >= 48) { PH_IDS(); const int gw2 = (bx - 48) * NWAVES + wave, NGW2 = (G - 48) * NWAVES;
                for (int it = gw2; it < 2048 * 2; it += NGW2) { const int bn = it >> 1, l2 = ((it & 1) << 7) + 2 * lane;
                    const int n = bn & 255, cp = n & 63, m = cp <= 32 ? cp : 64 - cp; const bool hasb = m >= 1 && m <= 31;
                    const u16* ra = UT + (size_t)((bn & ~63) + m) * 8192;
                    fft32_item(ra, ra + (size_t)32 * 8192, hasb, cp < 32 ? -1.0f : 1.0f, UF, bn >> 8, n, l2); } }
            else { pg8::Gemm g{Hb, WL + W_IN / 2, MROWS, NIN, DM}; pg8::RowOrder S; S.init(NIN, G, bx, sp == 0 ? 1 : 2);
                pg8::EpiInProj E{Pb, UT, UTCC, q_norm + l * 64, k_norm + l * 64};
                pg8::gemm_phase<pg8::EpiInProj, pg8::RowOrder, true, true>(ldsA, g, S, E); }
            GRID_BAR();
        }
        {
            PH_BASE();
            const int pair = vcu >> 4, jj = vcu & 15, b = pair >> 1, kvh = pair & 1;
            const attn_body::bf16* Pa = (const attn_body::bf16*)Pb; attn_body::bf16* Oa = (attn_body::bf16*)Ob;
            const int cid = ((vcu & 31) != 0) ? (vcu & 31) - 1 + 31 * (vcu >> 5) : 1000;
            const int nA = 6 + ((l == 0 && cid < 96) ? 1 : 0);
            float mfix; { float gq = 0.f, gk = 0.f;
#pragma unroll 8
                for (int j = 0; j < 64; ++j) { gq = __builtin_fmaxf(gq, __builtin_fabsf(q_norm[l * 64 + j])); gk = __builtin_fmaxf(gk, __builtin_fabsf(k_norm[l * 64 + j])); }
                mfix = __uint_as_float(__builtin_amdgcn_readfirstlane(__float_as_uint(64.0f * 1.02f * 0.125f * 1.4426950408889634f * gq * gk))); }
            const bool fixm = mfix <= 48.0f;
#pragma nounroll
            for (int i = 0; i < nA; ++i) {
                const attn_body::bf16 *Qu, *Kh, *Vh; attn_body::bf16* Ou; int NT; float sk = -INFINITY;
                if (i < 6) { const int idx = i * 16 + jj, hq = kvh * 3 + (idx >> 5), qb = idx & 31; const size_t r0 = (size_t)b * BR;
                    Qu = Pa + (r0 + CTX + qb * 256) * PQW + hq * 64; Kh = Pa + r0 * PQW + (6 + kvh) * 64; Vh = Pa + r0 * PQW + (8 + kvh) * 64; Ou = Oa + (r0 + CTX + qb * 256) * 1024 + hq * 64; NT = 132; }
                else { const int ty = cid / 48, rem = cid % 48, cb = rem / 6, hq = rem % 6, ckv = hq / 3; const size_t r0 = (size_t)cb * BR;
                    const int qc = ty ? 10 + hq : hq, kc = ty ? 16 + ckv : 6 + ckv, vc = ty ? 18 + ckv : 8 + ckv, oc = ty ? 640 + hq * 64 : hq * 64;
                    Qu = Pa + r0 * PQW + qc * 64; Kh = Pa + r0 * PQW + kc * 64; Vh = Pa + r0 * PQW + vc * 64; Ou = Oa + r0 * 1024 + oc; NT = 4;
                    if (ty) sk = sink[l * 6 + hq] * 1.4426950408889634f; }
#ifndef NO_ATTN_A
                if (i < 6 && fixm) attn_body::attn_unit<8, false, true>(Qu, Kh, Vh, Ou, NT, 0, 0, sk, mfix, (char*)lds);
                else attn_body::attn_unit<8, false, false>(Qu, Kh, Vh, Ou, NT, 0, 0, sk, 0.f, (char*)lds);
#endif
            }
#pragma nounroll
            for (int i = 0; i < 6; ++i) {
                const int idx = i * 16 + jj, hq = kvh * 3 + (idx >> 5), qb = idx & 31, q0 = qb * 256; const size_t r0 = (size_t)b * BR;
                const int kb0 = q0 >= 128 ? q0 - 128 : 0, ke = q0 + 384 <= SEQ ? q0 + 384 : SEQ, NT = 4 + (ke - kb0) / 64;
#ifndef NO_ATTN_W
                attn_body::attn_unit<8, true, false>(Pa + (r0 + CTX + q0) * PQW + (10 + hq) * 64, Pa + r0 * PQW + (16 + kvh) * 64, Pa + r0 * PQW + (18 + kvh) * 64,
                                              Oa + (r0 + CTX + q0) * 1024 + 640 + hq * 64, NT, kb0, q0 - kb0, sink[l * 6 + hq] * 1.4426950408889634f, 0.f, (char*)lds);
#endif
            }
            __syncthreads();
            const int nF = (l == 0) ? 2 : 1;
#pragma nounroll
            for (int v = 0; v < nF; ++v) {
                if (v == 1 && bx < 8) {
                    for (int idx = threadIdx.x; idx < 256 * 64; idx += NTHREADS) { const int n = idx >> 6, ch = idx & 63, which = ch >> 5, p0 = (ch & 31) << 3;
                        const int cp = n & 63, m = cp <= 32 ? cp : 64 - cp; const bool hasb = m >= 1 && m <= 31;
                        const u16* src = UTCC + (size_t)(bx * 256 + (n & ~63) + (which ? 32 + m : m)) * 256 + p0;
                        v4u w = (which && !hasb) ? (v4u){0u, 0u, 0u, 0u} : *(const v4u*)src;
                        if (which && cp > 32) { w.x ^= 0x80008000u; w.y ^= 0x80008000u; w.z ^= 0x80008000u; w.w ^= 0x80008000u; }
                        *(v4u*)(UTC + (size_t)(bx * 256 + n) * 512 + which * 256 + p0) = w; }
                    asm volatile("s_waitcnt vmcnt(0)" ::: "memory"); }
                __syncthreads();
                pg8::Gemm g = v == 0 ? pg8::Gemm{TC, UF, 256, 65536, 512} : pg8::Gemm{TC, UTC, 256, 2048, 512};
                pg8::StaticOrder S; S.init(g.M, g.N, G, bx);
                pg8::EpiFourier E{Ob, v == 0 ? 1 : 0, v == 0 ? 0.001381067932004976f : 0.0078125f};
                pg8::gemm_phase<pg8::EpiFourier, pg8::StaticOrder, true, true>(ldsA, g, S, E);
                __syncthreads();
            }
        }
        GRID_BAR();
        { PH_BASE(); pg8::Gemm g{Ob, WL + W_OUT / 2, MROWS, DM, DM}; pg8::RowOrder S; S.init(DM, G, bx, l == 1);
          pg8::EpiResid E{l == 0 ? x_in : nullptr, l == 0 ? ctx_in : nullptr, X, MODL + 2 * 1024};
          pg8::gemm_phase<pg8::EpiResid, pg8::RowOrder, true, true>(ldsA, g, S, E); }
        GRID_BAR();
        { PH_BASE(); PH_IDS();
        for (int row = 4 * gw; row < MROWS; row += 4 * NGW) { const int b = row / BR, p = row % BR; const bool is_ctx = p < CTX; const int r = is_ctx ? 8 : b;
            if (l == 1 && is_ctx) continue;
            norm4_rows<false, true>(X + (size_t)row * DM, MODL + (size_t)(r * 6 + 3) * 1024, MODL + (size_t)(r * 6 + 4) * 1024, Hb + (size_t)row * DM, lane); } }
        GRID_BAR();
        { PH_BASE(); pg8::Gemm g{Hb, WL + W_GU / 2, MROWS, NGU, DM}; pg8::RowOrder S; S.init(NGU, G, bx, l == 1);
          pg8::EpiSwiglu E{Gb};
          pg8::gemm_phase<pg8::EpiSwiglu, pg8::RowOrder, true, true>(ldsA, g, S, E); }
        GRID_BAR();
        { const int nsp = (l == 0) ? 2 : 1;
#pragma nounroll
          for (int sp = 0; sp < nsp; ++sp) {
            PH_BASE();
            if (sp == 1 && bx >= 32) { PH_IDS(); const int gw2 = (bx - 32) * NWAVES + wave, NGW2 = (G - 32) * NWAVES;
                for (int q = gw2; q < NB * SEQ / 4; q += NGW2) { const int b = q >> 11, row = b * BR + CTX + ((q & 2047) << 2);
                    norm4_rows<false, true>(X + (size_t)row * DM, MOD + (size_t)((9 + b) * 6 + 0) * 1024, MOD + (size_t)((9 + b) * 6 + 1) * 1024, Hb + (size_t)row * DM, lane); }
                conv_weights(w_in, w_out, w_gate, w_up, w_down, (u16*)(ws + WS_W), 1, gw2, NGW2, (LAS float*)(ldsA + wave * 16384), lane); }
            else { pg8::Gemm g{Gb, WL + W_DN / 2, MROWS, DM, FF}; pg8::RowOrder S; S.init(DM, G, bx, sp == 0 ? 1 : 2);
                pg8::EpiResid E{nullptr, nullptr, X, MODL + 5 * 1024};
                pg8::gemm_phase<pg8::EpiResid, pg8::RowOrder, true, true>(ldsA, g, S, E); }
            GRID_BAR();
          } }
    }
    { PH_BASE(); PH_IDS();
    for (int row = 4 * gw; row < NB * SEQ; row += 4 * NGW) { const int b = row >> 13, t = row & 8191;
        norm4_rows<true, true>(X + (size_t)(b * BR + CTX + t) * DM, g_final, nullptr, args.out + (size_t)row * DM, lane); } }
}

extern "C" void kernel_launch(void* const* d_in, const int* in_sizes, int n_in, void* d_out, int out_size, void* d_ws, size_t ws_size, hipStream_t stream) {
    static int grid = 0;
    if (grid == 0) {
        if (n_in != 17 || in_sizes[0] != NB * SEQ * DM || out_size != NB * SEQ * DM || ws_size < WS_END) {
            fprintf(stderr, "kernel_launch: unexpected shapes (n_in %d, in0 %d, out %d, ws %zu, need %zu); nothing launched\n", n_in, n_in > 0 ? in_sizes[0] : -1, out_size, ws_size, (size_t)WS_END); grid = -1; return; }
        int dev = 0, cus = 0, per_cu = 0;
        if (hipGetDevice(&dev) != hipSuccess || hipDeviceGetAttribute(&cus, hipDeviceAttributeMultiprocessorCount, dev) != hipSuccess) { fprintf(stderr, "kernel_launch: device query failed\n"); grid = -1; return; }
        if (hipFuncSetAttribute((const void*)hybrid_fwd, hipFuncAttributeMaxDynamicSharedMemorySize, LDS_BYTES) != hipSuccess) { fprintf(stderr, "kernel_launch: hipFuncSetAttribute failed\n"); grid = -1; return; }
        if (hipOccupancyMaxActiveBlocksPerMultiprocessor(&per_cu, (const void*)hybrid_fwd, NTHREADS, LDS_BYTES) != hipSuccess || per_cu < 1) { fprintf(stderr, "kernel_launch: occupancy query says %d blocks per CU\n", per_cu); per_cu = 1; }
        (void)hipGetLastError();
        grid = cus;
        if (grid != 256) fprintf(stderr, "kernel_launch: %d CUs; the mixer phase's static schedule assumes 256\n", grid);
    }
    if (grid < 0) return;
    Args a{};
    for (int i = 0; i < 17; ++i) a.in[i] = (const float*)d_in[i];
    a.out = (float*)d_out; a.ws = (unsigned char*)d_ws;
    void* kargs[] = {&a};
    const hipError_t e = hipLaunchCooperativeKernel((const void*)hybrid_fwd, dim3(grid), dim3(NTHREADS), kargs, LDS_BYTES, stream);
    if (e != hipSuccess) fprintf(stderr, "kernel_launch: cooperative launch failed: %s (grid %d)\n", hipGetErrorString(e), grid);
}
```
